# Optimizing an MI355X kernel written in HIP

```python
import jax, jax.numpy as jnp
from jax import lax
import numpy as np

D_MODEL = 1024
BATCH = 8
SEQ = 4096
DEPTH = 2

BRANCH_W = 512
N_BRANCH = 3
D_FF = 2816
MACARON_W = 0.5
EPS = 1e-6
NEG_INF = -1e30

GM_GROUPS = 4
GM_CH = BRANCH_W // GM_GROUPS
GM_CHUNK = 128

NSA_HEADS = 8
NSA_KV_GROUPS = 2
NSA_HPG = NSA_HEADS // NSA_KV_GROUPS
HEAD_DIM = 64
ROT_DIM = HEAD_DIM // 4
ROPE_THETA = 500000.0
CMP_BLOCK = 32
CMP_STRIDE = 16
CMP_HIDDEN = 2 * HEAD_DIM
SLC_BLOCK = 64
SLC_TOPK = 16
WINDOW = 512
NSA_QCHUNK = 64
FORCE_SCORE = 1e4

CONV_W = 3

A_COLS = 2 * BRANCH_W
Q_COLS = NSA_HEADS * HEAD_DIM
KV_COLS = 6 * NSA_KV_GROUPS * HEAD_DIM
NG_COLS = 3 * NSA_HEADS
C_COLS = 3 * BRANCH_W
IN_COLS = A_COLS + Q_COLS + KV_COLS + NG_COLS + C_COLS
IN_SPLITS = (A_COLS, A_COLS + Q_COLS, A_COLS + Q_COLS + KV_COLS,
             A_COLS + Q_COLS + KV_COLS + NG_COLS)

kernel_name = "hybrid_gmlp_nsa_shortconv_macaron"


def rmsnorm(x, g):
    xf = x.astype(jnp.float32)
    y = xf * lax.rsqrt(jnp.mean(xf * xf, axis=-1, keepdims=True) + EPS) * g
    return y.astype(x.dtype)


def layernorm(x, g, b):
    xf = x.astype(jnp.float32)
    mu = jnp.mean(xf, axis=-1, keepdims=True)
    var = jnp.mean(jnp.square(xf - mu), axis=-1, keepdims=True)
    return ((xf - mu) * lax.rsqrt(var + EPS) * g + b).astype(x.dtype)


def rope_tables(seq):
    pos = jnp.arange(seq, dtype=jnp.float32)
    inv = 1.0 / (ROPE_THETA ** (jnp.arange(0, ROT_DIM, 2, dtype=jnp.float32) / ROT_DIM))
    ang = pos[:, None] * inv[None, :]
    return jnp.cos(ang), jnp.sin(ang)


def apply_partial_rope(x, cos, sin):
    half = ROT_DIM // 2
    x1, x2, xp = x[..., :half], x[..., half:ROT_DIM], x[..., ROT_DIM:]
    r1 = (x1 * cos - x2 * sin).astype(x.dtype)
    r2 = (x2 * cos + x1 * sin).astype(x.dtype)
    return jnp.concatenate([r1, r2, xp], axis=-1)


def swiglu(h, w13, w2):
    g, u = jnp.split(h @ w13, 2, axis=-1)
    return (jax.nn.silu(g) * u) @ w2


def masked_softmax(s, mask, scale):
    s = jnp.where(mask, s.astype(jnp.float32) * scale, NEG_INF)
    p = jax.nn.softmax(s, axis=-1)
    return jnp.where(mask, p, 0.0)


def gmlp_spatial_gating(uv, ln_g, ln_b, w_s, b_s):
    Bsz, S, _ = uv.shape
    u, v = jnp.split(jax.nn.gelu(uv), 2, axis=-1)
    v = layernorm(v, ln_g, ln_b)
    v = v.reshape(Bsz, S // GM_CHUNK, GM_CHUNK, GM_GROUPS, GM_CH)
    tril = np.tril(np.ones((GM_CHUNK, GM_CHUNK), dtype=bool))
    ws = jnp.where(tril[None], w_s, 0.0)
    sv = jnp.einsum('gts,bnsgc->bntgc', ws, v) + b_s.T[:, :, None]
    return u * sv.reshape(Bsz, S, BRANCH_W)


def compress_blocks(k, pe, w1, w2):
    Bsz, G, S, hd = k.shape
    k16 = k.reshape(Bsz, G, S // CMP_STRIDE, CMP_STRIDE, hd)
    blocks = jnp.concatenate([k16[:, :, :-1], k16[:, :, 1:]], axis=3) + pe
    nc = blocks.shape[2]
    hid = jax.nn.gelu(jnp.einsum('bgnl,lh->bgnh', blocks.reshape(Bsz, G, nc, CMP_BLOCK * hd), w1))
    return jnp.einsum('bgnh,hd->bgnd', hid, w2)


def cmp_to_slc_matrix(seq):
    nc = seq // CMP_STRIDE - 1
    nb = seq // SLC_BLOCK
    cs = np.arange(nc)[:, None] * CMP_STRIDE
    ss = np.arange(nb)[None, :] * SLC_BLOCK
    ov = np.clip(np.minimum(cs + CMP_BLOCK, ss + SLC_BLOCK) - np.maximum(cs, ss), 0, None)
    return (ov / CMP_BLOCK).astype(np.float32)


def native_sparse_attention(q, kv, gate_logits, cmp_pe, cmp_w1, cmp_w2, cos, sin):
    Bsz, S, _ = q.shape
    G, HPG, hd = NSA_KV_GROUPS, NSA_HPG, HEAD_DIM
    scale = HEAD_DIM ** -0.5
    qh = q.reshape(Bsz, S, G, HPG, hd).transpose(0, 2, 3, 1, 4)
    kvh = kv.reshape(Bsz, S, 6, G, hd).transpose(2, 0, 3, 1, 4)
    k_cmp, v_cmp, k_slc, v_slc, k_win, v_win = kvh
    gates = jax.nn.sigmoid(gate_logits.reshape(Bsz, S, G, HPG, 3).transpose(0, 2, 3, 1, 4))

    q_rot = apply_partial_rope(qh, cos, sin)
    k_slc = apply_partial_rope(k_slc, cos, sin)
    k_win = apply_partial_rope(k_win, cos, sin)

    kc = compress_blocks(k_cmp, cmp_pe[0], cmp_w1[0], cmp_w2[0])
    vc = compress_blocks(v_cmp, cmp_pe[1], cmp_w1[1], cmp_w2[1])
    nc = kc.shape[2]
    cmp_end = jnp.asarray((np.arange(nc) * CMP_STRIDE + CMP_BLOCK - 1).astype(np.int32))
    slc_map = jnp.asarray(cmp_to_slc_matrix(S))
    nb = S // SLC_BLOCK
    n_sel = min(SLC_TOPK, nb)
    k_slc_blk = k_slc.reshape(Bsz, G, nb, SLC_BLOCK, hd)
    v_slc_blk = v_slc.reshape(Bsz, G, nb, SLC_BLOCK, hd)
    pad = ((0, 0), (0, 0), (WINDOW, 0), (0, 0))
    k_win_pad = jnp.pad(k_win, pad)
    v_win_pad = jnp.pad(v_win, pad)
    bi = jnp.arange(Bsz)[:, None, None, None]
    gi = jnp.arange(G)[None, :, None, None]
    blk = jnp.arange(nb)

    def query_block(i):
        q0 = i * NSA_QCHUNK
        t = q0 + jnp.arange(NSA_QCHUNK)
        qn = lax.dynamic_slice_in_dim(qh, q0, NSA_QCHUNK, axis=3)
        qr = lax.dynamic_slice_in_dim(q_rot, q0, NSA_QCHUNK, axis=3)
        gc = lax.dynamic_slice_in_dim(gates, q0, NSA_QCHUNK, axis=3)

        s = jnp.einsum('bghqd,bgnd->bghqn', qn, kc)
        p_cmp = masked_softmax(s, cmp_end[None, :] <= t[:, None], scale)
        o_cmp = jnp.einsum('bghqn,bgnd->bghqd', p_cmp.astype(vc.dtype), vc)

        imp = jnp.einsum('bghqn,nj->bgqj', p_cmp, slc_map)
        cur = t // SLC_BLOCK
        forced = (blk[None, :] == 0) | (blk[None, :] == cur[:, None]) | (blk[None, :] == cur[:, None] - 1)
        causal_blk = blk[None, :] <= cur[:, None]
        score = jnp.where(forced, FORCE_SCORE, jnp.where(causal_blk, imp, -1.0))
        _, idx = lax.top_k(score, n_sel)
        kg = k_slc_blk[bi, gi, idx]
        vg = v_slc_blk[bi, gi, idx]
        kpos = idx[..., None] * SLC_BLOCK + jnp.arange(SLC_BLOCK)
        m_slc = (kpos <= t[:, None, None]).reshape(Bsz, G, 1, NSA_QCHUNK, n_sel * SLC_BLOCK)
        s = jnp.einsum('bghqd,bgqnkd->bghqnk', qr, kg).reshape(Bsz, G, HPG, NSA_QCHUNK, n_sel * SLC_BLOCK)
        p = masked_softmax(s, m_slc, scale)
        o_slc = jnp.einsum('bghqm,bgqmd->bghqd', p.astype(vg.dtype),
                           vg.reshape(Bsz, G, NSA_QCHUNK, n_sel * SLC_BLOCK, hd))

        kw = lax.dynamic_slice_in_dim(k_win_pad, q0, WINDOW + NSA_QCHUNK, axis=2)
        vw = lax.dynamic_slice_in_dim(v_win_pad, q0, WINDOW + NSA_QCHUNK, axis=2)
        wpos = q0 - WINDOW + jnp.arange(WINDOW + NSA_QCHUNK)
        d = t[:, None] - wpos[None, :]
        m_win = (d >= 0) & (d < WINDOW) & (wpos[None, :] >= 0)
        s = jnp.einsum('bghqd,bgkd->bghqk', qr, kw)
        p = masked_softmax(s, m_win, scale)
        o_win = jnp.einsum('bghqk,bgkd->bghqd', p.astype(vw.dtype), vw)

        return gc[..., 0:1] * o_cmp + gc[..., 1:2] * o_slc + gc[..., 2:3] * o_win

    out = lax.map(query_block, jnp.arange(S // NSA_QCHUNK))
    return out.transpose(1, 0, 4, 2, 3, 5).reshape(Bsz, S, NSA_HEADS * hd)


def short_gated_conv(bcx, conv_w):
    b_g, c_g, xt = jnp.split(bcx, 3, axis=-1)
    h = c_g * xt
    y = lax.conv_general_dilated(h, conv_w[:, None, :], window_strides=(1,),
                                 padding=[(CONV_W - 1, 0)],
                                 dimension_numbers=('NWC', 'WIO', 'NWC'),
                                 feature_group_count=BRANCH_W)
    return b_g * y


def token_mixing(h, w_in, gm_ln_g, gm_ln_b, gm_ws, gm_bs, cmp_pe, cmp_w1, cmp_w2,
                 conv_w, w_branch, w_gate, w_out, cos, sin):
    Bsz, S, _ = h.shape
    proj = h @ w_in
    a_in, q_in, kv_in, ng_in, c_in = jnp.split(proj, IN_SPLITS, axis=-1)
    y_a = gmlp_spatial_gating(a_in, gm_ln_g, gm_ln_b, gm_ws, gm_bs)
    y_b = native_sparse_attention(q_in, kv_in, ng_in, cmp_pe, cmp_w1, cmp_w2, cos, sin)
    y_c = short_gated_conv(c_in, conv_w)
    ys = jnp.stack([y_a, y_b, y_c], axis=2)
    branches = jnp.einsum('bsnw,nwd->bsnd', ys, w_branch)
    gates = jax.nn.sigmoid(h @ w_gate).reshape(Bsz, S, N_BRANCH, D_MODEL)
    merged = jnp.einsum('bsnd,bsnd->bsd', gates, branches)
    return merged @ w_out


def pre_norm_modulate(x, g, shift, scale):
    return rmsnorm(x, g) * (1.0 + scale[:, None, :]) + shift[:, None, :]


def post_norm_residual(x, y, g, gate, res_w):
    return x + res_w * gate[:, None, :] * rmsnorm(y, g)


def setup_inputs(seed: int = 0) -> dict:
    key = jax.random.key(seed)
    ks = jax.random.split(key, 20)
    L = DEPTH

    def nrm(k, shape, fan_in, gain=1.0):
        return gain * fan_in ** -0.5 * jax.random.normal(k, shape, jnp.float32)

    def noise(k, shape, s):
        return s * jax.random.normal(k, shape, jnp.float32)

    return {
        "x": jax.random.normal(ks[0], (BATCH, SEQ, D_MODEL), jnp.float32),
        "c": jax.random.normal(ks[1], (BATCH, D_MODEL), jnp.float32),
        "mod_w": nrm(ks[2], (L, D_MODEL, 9 * D_MODEL), D_MODEL, 0.5),
        "mod_b": noise(ks[3], (L, 9 * D_MODEL), 0.02),
        "norm_g": 1.0 + noise(ks[4], (L, 6, D_MODEL), 0.05),
        "ffn_w13": nrm(ks[5], (L, 2, D_MODEL, 2 * D_FF), D_MODEL),
        "ffn_w2": nrm(ks[6], (L, 2, D_FF, D_MODEL), D_FF),
        "w_in": nrm(ks[7], (L, D_MODEL, IN_COLS), D_MODEL),
        "gm_ln_g": 1.0 + noise(ks[8], (L, BRANCH_W), 0.05),
        "gm_ln_b": noise(ks[9], (L, BRANCH_W), 0.02),
        "gm_ws": nrm(ks[10], (L, GM_GROUPS, GM_CHUNK, GM_CHUNK), GM_CHUNK),
        "gm_bs": 1.0 + noise(ks[11], (L, GM_GROUPS, GM_CHUNK), 0.05),
        "cmp_pe": noise(ks[12], (L, 2, CMP_BLOCK, HEAD_DIM), 0.1),
        "cmp_w1": nrm(ks[13], (L, 2, CMP_BLOCK * HEAD_DIM, CMP_HIDDEN), CMP_BLOCK * HEAD_DIM),
        "cmp_w2": nrm(ks[14], (L, 2, CMP_HIDDEN, HEAD_DIM), CMP_HIDDEN),
        "conv_w": nrm(ks[15], (L, CONV_W, BRANCH_W), CONV_W),
        "w_branch": nrm(ks[16], (L, N_BRANCH, BRANCH_W, D_MODEL), BRANCH_W),
        "w_gate": nrm(ks[17], (L, D_MODEL, N_BRANCH * D_MODEL), D_MODEL),
        "w_out": nrm(ks[18], (L, D_MODEL, D_MODEL), D_MODEL),
    }


def reference(x, c, mod_w, mod_b, norm_g, ffn_w13, ffn_w2, w_in, gm_ln_g, gm_ln_b,
              gm_ws, gm_bs, cmp_pe, cmp_w1, cmp_w2, conv_w, w_branch, w_gate, w_out):
    Bsz, S, _ = x.shape
    cos, sin = rope_tables(S)
    c_act = jax.nn.silu(c)
    for l in range(DEPTH):
        mod = (c_act @ mod_w[l] + mod_b[l]).reshape(Bsz, 9, D_MODEL)
        h = pre_norm_modulate(x, norm_g[l, 0], mod[:, 0], mod[:, 1])
        x = post_norm_residual(x, swiglu(h, ffn_w13[l, 0], ffn_w2[l, 0]), norm_g[l, 1], mod[:, 2], MACARON_W)
        h = pre_norm_modulate(x, norm_g[l, 2], mod[:, 3], mod[:, 4])
        y = token_mixing(h, w_in[l], gm_ln_g[l], gm_ln_b[l], gm_ws[l], gm_bs[l], cmp_pe[l],
                         cmp_w1[l], cmp_w2[l], conv_w[l], w_branch[l], w_gate[l], w_out[l], cos, sin)
        x = post_norm_residual(x, y, norm_g[l, 3], mod[:, 5], 1.0)
        h = pre_norm_modulate(x, norm_g[l, 4], mod[:, 6], mod[:, 7])
        x = post_norm_residual(x, swiglu(h, ffn_w13[l, 1], ffn_w2[l, 1]), norm_g[l, 5], mod[:, 8], MACARON_W)
    return x
```

```cpp
#include <hip/hip_runtime.h>
#include <hip/hip_cooperative_groups.h>
#include <cstdio>
#include <cstdint>
namespace cg = cooperative_groups;
__device__ __forceinline__ int opaque_tid() { int t = (int)threadIdx.x; asm volatile("" : "+v"(t)); return t; }
namespace pg8 {
#define PG8_LAS __attribute__((address_space(3)))
typedef unsigned short bf16_t;
typedef short bf16x8 __attribute__((ext_vector_type(8)));
typedef float f32x4 __attribute__((ext_vector_type(4)));
typedef unsigned u32x4 __attribute__((ext_vector_type(4)));
constexpr int BM = 256, BK = 64, HALF = 128, HTB = HALF * BK * 2  , STAGE_BYTES = 8 * HTB, NXCD = 8, WGM = 4;

__host__ __device__ __forceinline__ int lds_byte(int r, int c) { const int st = (r >> 4) * 2 + (c >> 5), rr = r & 15, cc = c & 31, ob = rr * 64 + cc * 2; return st * 1024 + (ob ^ (((ob >> 9) & 1) << 5)); }
__host__ __device__ __forceinline__ void stage_rc(int b, int& R, int& C) { const int st = b / 1024, sb = b % 1024, swz = sb ^ (((sb >> 9) & 1) << 5); R = (st >> 1) * 16 + swz / 64; C = (st & 1) * 32 + (swz % 64) / 2; }
__host__ __device__ __forceinline__ int perm32(int rho) { const int n = rho >> 4, i = rho & 15; return 8 * (i >> 2) + 4 * n + (i & 3); }

struct Unit { int pm, pn; };
struct Gemm { const bf16_t* A; const bf16_t* Bt; int M, N, K, lda, ldb, adiv, aoff; };

struct StaticOrder {
    int nM, nN, nwg, G, c;
    __host__ __device__ void init(int M, int N, int G_, int c_) { nM = M / BM; nN = N / BM; nwg = nM * nN; G = G_; c = c_; }
    __host__ __device__ bool next(int i, Unit& u) const {
        const long L = (long)i * G + c; if (L >= nwg) return false;
        int wgid = (int)L; { const int q = nwg / NXCD, r = nwg % NXCD, xcd = wgid % NXCD, off = wgid / NXCD; wgid = (xcd < r ? xcd * (q + 1) : r * (q + 1) + (xcd - r) * q) + off; }
        const int nig = WGM * nN, gid = wgid / nig, fm = gid * WGM, gsz = (nM - fm) < WGM ? (nM - fm) : WGM;
        u.pm = fm + ((wgid % nig) % gsz); u.pn = (wgid % nig) / gsz; return true;
    }
    __device__ __forceinline__ void a_ready(const Unit&) const {}
    __device__ __forceinline__ void done(const Unit&) const {}
};
typedef float f32x2c __attribute__((ext_vector_type(2)));
typedef __bf16 bf16x2c __attribute__((ext_vector_type(2)));
__device__ __forceinline__ unsigned cvt_pk_bf16(float lo, float hi) { const f32x2c v = {lo, hi}; const bf16x2c r = __builtin_convertvector(v, bf16x2c); return __builtin_bit_cast(unsigned, r); }
template <class Epi, class Sched, bool ALIGN_EPI = false, bool SP2 = false>
__device__ __forceinline__ void gemm_phase(PG8_LAS unsigned char* lds, const Gemm g, const Sched& S, const Epi& E) {
    const int tid = opaque_tid(), wid = __builtin_amdgcn_readfirstlane(tid >> 6), lane = tid & 63, wr = wid >> 2, wc = wid & 3, fr = lane & 15, fq = lane >> 4;
    const int K = g.K, nt = K / BK;
    unsigned voffA[2], voffB[2];
#pragma unroll
    for (int i = 0; i < 2; ++i) { int R, C; stage_rc(tid * 16 + i * 8192, R, C); const int Rb = Epi::PERM ? ((R & ~31) + perm32(R & 31)) : R;
        voffA[i] = (unsigned)(R * g.lda + C) * 2u; voffB[i] = (unsigned)(Rb * g.ldb + C) * 2u; }
    const size_t kstep = (size_t)(BK * 2);
    const size_t hstepA = (size_t)HALF * g.lda * 2, hstepB = (size_t)HALF * g.ldb * 2;
    const size_t tstepA = 2 * hstepA, tstepB = 2 * hstepB;
    const unsigned ldsw = (unsigned)wid * 1024u;
    const int aoff = lds_byte(wr * 64 + fr, fq * 8), boff = lds_byte(wc * 32 + fr, fq * 8);
#define PG8_SA(b, h) (((b) * 2 + (h)) * HTB)
#define PG8_SB(b, h) ((4 + (b) * 2 + (h)) * HTB)
#define PG8_STAGE(bufoff, gbase, voff) do { _Pragma("unroll") for (int _i = 0; _i < 2; ++_i) \
        __builtin_amdgcn_global_load_lds((const unsigned*)((const char*)(gbase) + (voff)[_i]), (PG8_LAS unsigned*)(lds + (bufoff) + ldsw + _i * 8192), 16, 0, 0); } while (0)
#define PG8_LDA(dst, b, h) do { _Pragma("unroll") for (int m = 0; m < 4; ++m) _Pragma("unroll") for (int k = 0; k < 2; ++k) dst[m][k] = *(const PG8_LAS bf16x8*)(lds + PG8_SA(b, h) + aoff + m * 2048 + k * 1024); } while (0)
#define PG8_LDB(dst, b, h) do { _Pragma("unroll") for (int n = 0; n < 2; ++n) _Pragma("unroll") for (int k = 0; k < 2; ++k) dst[n][k] = *(const PG8_LAS bf16x8*)(lds + PG8_SB(b, h) + boff + n * 2048 + k * 1024); } while (0)
#define PG8_MMA(ai, bj, At, Bt) do { __builtin_amdgcn_s_setprio(1); _Pragma("unroll") for (int m = 0; m < 4; ++m) _Pragma("unroll") for (int n = 0; n < 2; ++n) _Pragma("unroll") for (int k = 0; k < 2; ++k) \
        acc[ai][bj][m][n] = __builtin_amdgcn_mfma_f32_16x16x32_bf16(Bt[n][k], At[m][k], acc[ai][bj][m][n], 0, 0, 0); __builtin_amdgcn_s_setprio(0); } while (0)
#define PG8_WAIT_V(n) asm volatile("s_waitcnt vmcnt(" #n ")" ::: "memory")
#define PG8_WAIT_L(n) asm volatile("s_waitcnt lgkmcnt(" #n ")" ::: "memory")
#define PG8_BAR __builtin_amdgcn_s_barrier()
#define PG8_SCHED __builtin_amdgcn_sched_barrier(0)
    Unit cur, nxt; int ui = 0;
    if (!S.next(0, cur)) return;
    f32x4 acc[2][2][4][2];
#pragma unroll
    for (int a = 0; a < 2; ++a)
#pragma unroll
        for (int b = 0; b < 2; ++b)
#pragma unroll
            for (int m = 0; m < 4; ++m)
#pragma unroll
                for (int n = 0; n < 2; ++n) acc[a][b][m][n] = (f32x4){0.f, 0.f, 0.f, 0.f};
    bf16x8 At[4][2], B0[2][2], B1[2][2];
    const char* cA = (const char*)g.A + (size_t)cur.pm * tstepA + (size_t)(cur.pn / g.adiv) * g.aoff * 2; const char* cB = (const char*)g.Bt + (size_t)cur.pn * tstepB;
    S.a_ready(cur);
    if constexpr (SP2) {
        PG8_STAGE(PG8_SB(0, 0), cB, voffB); PG8_STAGE(PG8_SB(0, 1), cB + hstepB, voffB); PG8_STAGE(PG8_SA(0, 0), cA, voffA); PG8_STAGE(PG8_SA(0, 1), cA + hstepA, voffA);
        if (wr == 1) PG8_BAR;
        PG8_WAIT_V(2); PG8_BAR;
        PG8_STAGE(PG8_SB(1, 0), cB + kstep, voffB); PG8_STAGE(PG8_SA(1, 0), cA + kstep, voffA); PG8_STAGE(PG8_SB(1, 1), cB + hstepB + kstep, voffB);
        PG8_WAIT_V(6); PG8_BAR;
    } else {
        PG8_STAGE(PG8_SB(0, 0), cB, voffB); PG8_STAGE(PG8_SA(0, 0), cA, voffA); PG8_STAGE(PG8_SB(0, 1), cB + hstepB, voffB); PG8_STAGE(PG8_SA(0, 1), cA + hstepA, voffA);
        if (wr == 1) PG8_BAR;
        PG8_WAIT_V(4); PG8_BAR;
        PG8_STAGE(PG8_SB(1, 0), cB + kstep, voffB); PG8_STAGE(PG8_SA(1, 0), cA + kstep, voffA); PG8_STAGE(PG8_SB(1, 1), cB + hstepB + kstep, voffB);
        PG8_WAIT_V(6); PG8_BAR;
    }
    for (;;) {
        const bool has_next = S.next(ui + 1, nxt);
        const char* nA = has_next ? (const char*)g.A + (size_t)nxt.pm * tstepA + (size_t)(nxt.pn / g.adiv) * g.aoff * 2 : cA; const char* nB = has_next ? (const char*)g.Bt + (size_t)nxt.pn * tstepB : cB;
        for (int t = 0; t < nt; t += 2) {
            const bool last = (t == nt - 2);
            const char* a1 = cA + (size_t)(t + 1) * kstep;
            const char* a2 = last ? nA : cA + (size_t)(t + 2) * kstep; const char* b2 = last ? nB : cB + (size_t)(t + 2) * kstep;
            const char* a3 = a2 + kstep; const char* b3 = b2 + kstep;
            if (last && has_next) S.a_ready(nxt);
            if constexpr (SP2) {
            PG8_LDB(B0, 0, 0); PG8_LDB(B1, 0, 1); PG8_SCHED; PG8_LDA(At, 0, 0); PG8_STAGE(PG8_SA(1, 1), a1 + hstepA, voffA);
            PG8_WAIT_V(8); PG8_WAIT_L(0); PG8_BAR; PG8_MMA(0, 0, At, B0); PG8_MMA(0, 1, At, B1); PG8_BAR; PG8_SCHED;
            PG8_LDA(At, 0, 1); PG8_STAGE(PG8_SB(0, 0), b2, voffB); PG8_STAGE(PG8_SB(0, 1), b2 + hstepB, voffB); PG8_STAGE(PG8_SA(0, 0), a2, voffA);
            PG8_WAIT_V(8); PG8_WAIT_L(0); PG8_BAR; PG8_MMA(1, 0, At, B0); PG8_MMA(1, 1, At, B1); PG8_BAR; PG8_SCHED;
            PG8_LDB(B0, 1, 0); PG8_LDB(B1, 1, 1); PG8_SCHED; PG8_LDA(At, 1, 0); PG8_STAGE(PG8_SA(0, 1), a2 + hstepA, voffA);
            PG8_WAIT_V(8); PG8_WAIT_L(0); PG8_BAR; PG8_MMA(0, 0, At, B0); PG8_MMA(0, 1, At, B1); PG8_BAR; PG8_SCHED;
            PG8_LDA(At, 1, 1); PG8_STAGE(PG8_SB(1, 0), b3, voffB); PG8_STAGE(PG8_SB(1, 1), b3 + hstepB, voffB); PG8_STAGE(PG8_SA(1, 0), a3, voffA);
            PG8_WAIT_V(8); PG8_WAIT_L(0); PG8_BAR; PG8_MMA(1, 0, At, B0); PG8_MMA(1, 1, At, B1); PG8_BAR; PG8_SCHED;
            } else {
            PG8_LDB(B0, 0, 0); PG8_SCHED; PG8_LDA(At, 0, 0); PG8_STAGE(PG8_SA(1, 1), a1 + hstepA, voffA);
            PG8_WAIT_L(8); PG8_BAR; PG8_WAIT_L(0); PG8_MMA(0, 0, At, B0); PG8_BAR; PG8_SCHED;
            PG8_LDB(B1, 0, 1); PG8_STAGE(PG8_SB(0, 0), b2, voffB);
            PG8_BAR; PG8_WAIT_L(0); PG8_MMA(0, 1, At, B1); PG8_BAR;
            PG8_LDA(At, 0, 1); PG8_STAGE(PG8_SA(0, 0), a2, voffA);
            PG8_BAR; PG8_WAIT_L(0); PG8_MMA(1, 0, At, B0); PG8_BAR; PG8_SCHED;
            PG8_STAGE(PG8_SB(0, 1), b2 + hstepB, voffB);
            PG8_WAIT_V(6); PG8_BAR; PG8_MMA(1, 1, At, B1); PG8_BAR;
            PG8_LDB(B0, 1, 0); PG8_SCHED; PG8_LDA(At, 1, 0); PG8_STAGE(PG8_SA(0, 1), a2 + hstepA, voffA);
            PG8_WAIT_L(8); PG8_BAR; PG8_WAIT_L(0); PG8_MMA(0, 0, At, B0); PG8_BAR; PG8_SCHED;
            PG8_LDB(B1, 1, 1); PG8_STAGE(PG8_SB(1, 0), b3, voffB);
            PG8_BAR; PG8_WAIT_L(0); PG8_MMA(0, 1, At, B1); PG8_BAR;
            PG8_LDA(At, 1, 1); PG8_STAGE(PG8_SA(1, 0), a3, voffA);
            PG8_BAR; PG8_WAIT_L(0); PG8_MMA(1, 0, At, B0); PG8_BAR; PG8_SCHED;
            PG8_STAGE(PG8_SB(1, 1), b3 + hstepB, voffB);
            PG8_WAIT_V(6); PG8_BAR; PG8_MMA(1, 1, At, B1); PG8_BAR;
            }
        }
        if constexpr (ALIGN_EPI) { if (wr == 0) PG8_BAR; }
        if constexpr (!Epi::AFTER_DRAIN) { E(acc, cur, wr, wc, fr, fq); S.done(cur); }
        if (!has_next) break;
#pragma unroll
        for (int a = 0; a < 2; ++a)
#pragma unroll
            for (int b = 0; b < 2; ++b)
#pragma unroll
                for (int m = 0; m < 4; ++m)
#pragma unroll
                    for (int n = 0; n < 2; ++n) acc[a][b][m][n] = (f32x4){0.f, 0.f, 0.f, 0.f};
        cur = nxt; cA = nA; cB = nB; ++ui;
        if constexpr (ALIGN_EPI) { if (wr == 1) PG8_BAR; }
    }
    PG8_WAIT_V(0);
    if constexpr (!ALIGN_EPI) { if (wr == 0) PG8_BAR; }
    PG8_BAR;
    if constexpr (Epi::AFTER_DRAIN) { E.fused(acc, cur, wr, wc, fr, fq, lds, wid, lane); S.done(cur); }
#undef PG8_SA
#undef PG8_SB
#undef PG8_STAGE
#undef PG8_LDA
#undef PG8_LDB
#undef PG8_MMA
#undef PG8_WAIT_V
#undef PG8_WAIT_L
#undef PG8_BAR
#undef PG8_SCHED
}
}

using pg8::bf16_t; using pg8::bf16x8; using pg8::f32x4; using pg8::cvt_pk_bf16;
#define LAS __attribute__((address_space(3)))
typedef unsigned u32x2 __attribute__((ext_vector_type(2)));
typedef unsigned u32x4v __attribute__((ext_vector_type(4)));
typedef unsigned long long u64;

constexpr int DM = 1024, NB = 8, SQ = 4096, NTOK = NB * SQ, DFF = 2816, INC = 3864;
constexpr int NTHR = 512;
constexpr int LDS_BYTES = 147456;

enum { I_X = 0, I_C, I_MODW, I_MODB, I_NORMG, I_W13, I_W2, I_WIN, I_LNG, I_LNB, I_GWS, I_GBS, I_PE, I_CW1, I_CW2, I_CONVW, I_WBR, I_WGATE, I_WOUT, N_IN };

constexpr size_t SZ_W13 = (size_t)5632 * 1024 * 2, SZ_W2 = (size_t)1024 * 2816 * 2;
constexpr size_t WS_W13 = 0;
constexpr size_t WS_W2 = WS_W13 + 2 * SZ_W13;
constexpr size_t WS_WIN = WS_W2 + 2 * SZ_W2;
constexpr size_t WS_WG = WS_WIN + (size_t)4096 * 1024 * 2;
constexpr size_t WS_WB = WS_WG + (size_t)3072 * 1024 * 2;
constexpr size_t WS_WO3 = WS_WB + (size_t)3072 * 512 * 2;
constexpr size_t WS_WC1 = WS_WO3 + (size_t)1024 * 3072 * 2;
constexpr size_t WS_H = WS_WC1 + (size_t)2 * 256 * 2048 * 2;
constexpr size_t WS_R1 = WS_H + (size_t)NTOK * DM * 2;
constexpr size_t SZ_R1 = (size_t)253 * 1024 * 1024 - 0;
constexpr size_t WS_R2 = WS_R1 + (size_t)241 * 1024 * 1024;
constexpr size_t WS_NG = WS_R2 + (size_t)NTOK * 1536 * 2;
constexpr size_t WS_HID = WS_NG + (size_t)NTOK * 24 * 4;
constexpr size_t WS_KC = WS_HID + (size_t)2 * 4096 * 128 * 2;
constexpr size_t WS_MOD = WS_KC + (size_t)2 * 16 * 256 * 64 * 2;
constexpr size_t WS_ROPE = WS_MOD + (size_t)2 * 8 * 9216 * 4;
constexpr size_t WS_CB1 = WS_ROPE + (size_t)4096 * 16 * 4;
constexpr size_t WS_BAR = WS_CB1 + 4096;
constexpr size_t WS_UL = WS_BAR + 16384;
constexpr size_t WS_END = WS_UL + (size_t)4 * 4096 * 256 * 4;
constexpr size_t R1_ACT = 0, R1_Y1 = (size_t)NTOK * DFF * 2;
constexpr size_t R1_AIN = 0, R1_Q = (size_t)NTOK * 1024 * 2, R1_KV = R1_Q + (size_t)NTOK * 512 * 2, R1_C = R1_KV + (size_t)6 * 16 * 4096 * 64 * 2 + 4096;
constexpr size_t R1_GATES = 0;
static_assert(R1_C + (size_t)NTOK * 1536 * 2 <= (size_t)241 * 1024 * 1024, "R1");
static_assert(R1_Y1 + (size_t)NTOK * DM * 2 <= (size_t)241 * 1024 * 1024, "R1b");
constexpr size_t KVSZ = (size_t)16 * 4096 * 64;

struct Args { const float* in[N_IN]; float* out; unsigned char* ws; };

__device__ __forceinline__ float bf2f(unsigned short v) { return __uint_as_float((unsigned)v << 16); }
__device__ __forceinline__ unsigned short f2bf(float f) { return (unsigned short)(cvt_pk_bf16(f, 0.f) & 0xffffu); }
__device__ __forceinline__ float gelu_t(float x) { const float u = 0.7978845608f * (x + 0.044715f * x * x * x); return x * __builtin_amdgcn_rcpf(1.f + __builtin_amdgcn_exp2f(-2.885390082f * u)); }
__device__ __forceinline__ float sigm(float x) { return __builtin_amdgcn_rcpf(1.f + __builtin_amdgcn_exp2f(-1.4426950408889634f * x)); }
__device__ __forceinline__ float wave_sum(float v) {
#pragma unroll
    for (int o = 32; o >= 1; o >>= 1) v += __shfl_xor(v, o);
    return v;
}

struct CmId { __device__ int operator()(int n) const { return n; } };
struct CmW13 { __device__ int operator()(int n) const { const int t = n >> 8, r = n & 255; return r < 128 ? t * 128 + r : DFF + t * 128 + (r - 128); } };
struct CmWin { __device__ int operator()(int n) const { return n < 2304 ? n : (n < 3840 ? n + 24 : (n < 3864 ? n - 3840 + 2304 : -1)); } };
struct CmC1 { __device__ int operator()(int n) const { return n < 128 ? n : -1; } };

struct TJob { const float* src; bf16_t* dst; int ld_src, ld_dst, ntk, cm; };
__device__ __forceinline__ int tj_col(int cm, int n) {
    if (cm == 1) { const int t = n >> 8, r = n & 255; return r < 128 ? t * 128 + r : DFF + t * 128 + (r - 128); }
    if (cm == 2) return n < 2304 ? n : (n < 3840 ? n + 24 : (n < 3864 ? n - 3840 + 2304 : -1));
    return n;
}
__device__ __forceinline__ void transpose_tile(const TJob& jb, int t, LAS float* tl, int otid) {
    const int j = otid & 63, i = otid >> 6;
    const int tn = t / jb.ntk, tk = t - tn * jb.ntk, n0 = tn * 64, k0 = tk * 128;
    const int sc = tj_col(jb.cm, n0 + j);
    float v[16];
#pragma unroll
    for (int kk = 0; kk < 16; ++kk) v[kk] = sc >= 0 ? jb.src[(size_t)(k0 + i + kk * 8) * jb.ld_src + sc] : 0.f;
#pragma unroll
    for (int kk = 0; kk < 16; ++kk) tl[(i + kk * 8) * 65 + j] = v[kk];
    __syncthreads();
    const int r = otid >> 3, c8 = (otid & 7) * 8;
#pragma unroll
    for (int hh = 0; hh < 2; ++hh) {
        const int cb = hh * 64 + c8;
        u32x4v w;
        w.x = cvt_pk_bf16(tl[(cb + 0) * 65 + r], tl[(cb + 1) * 65 + r]); w.y = cvt_pk_bf16(tl[(cb + 2) * 65 + r], tl[(cb + 3) * 65 + r]);
        w.z = cvt_pk_bf16(tl[(cb + 4) * 65 + r], tl[(cb + 5) * 65 + r]); w.w = cvt_pk_bf16(tl[(cb + 6) * 65 + r], tl[(cb + 7) * 65 + r]);
        *(u32x4v*)(jb.dst + (size_t)(n0 + r) * jb.ld_dst + k0 + cb) = w;
    }
    __syncthreads();
}

#define TJ_JOB(SRC, LDSRC, KK, NP, CM, DST, LDDST) { const int nt_ = ((KK) / 128) * ((NP) / 64); if (!found) { if (tt < nt_) { found = true; jb.src = (SRC); jb.dst = (DST); jb.ld_src = (LDSRC); jb.ld_dst = (LDDST); jb.ntk = (KK) / 128; jb.cm = (CM); } else tt -= nt_; } }
__device__ __forceinline__ void convert_weights(const Args& a, int l, LAS unsigned char* lds) {
    const int otid = opaque_tid();
    LAS float* tl = (LAS float*)lds;
    unsigned char* ws = a.ws;
    constexpr int TOTAL = 2 * (8 * 88) + 2 * (22 * 16) + 8 * 64 + 8 * 48 + 3 * (4 * 16) + 8 * 16 + 4 * (8 * 2);
    for (int t = blockIdx.x; t < TOTAL; t += gridDim.x) {
        int tt = t; bool found = false; TJob jb; jb.src = nullptr; jb.dst = nullptr; jb.ld_src = 0; jb.ld_dst = 0; jb.ntk = 1; jb.cm = 0;
        TJ_JOB(a.in[I_W13] + (size_t)(l * 2 + 0) * 1024 * 5632, 5632, 1024, 5632, 1, (bf16_t*)(ws + WS_W13), 1024)
        TJ_JOB(a.in[I_W13] + (size_t)(l * 2 + 1) * 1024 * 5632, 5632, 1024, 5632, 1, (bf16_t*)(ws + WS_W13 + SZ_W13), 1024)
        TJ_JOB(a.in[I_W2] + (size_t)(l * 2 + 0) * 2816 * 1024, 1024, 2816, 1024, 0, (bf16_t*)(ws + WS_W2), 2816)
        TJ_JOB(a.in[I_W2] + (size_t)(l * 2 + 1) * 2816 * 1024, 1024, 2816, 1024, 0, (bf16_t*)(ws + WS_W2 + SZ_W2), 2816)
        TJ_JOB(a.in[I_WIN] + (size_t)l * 1024 * INC, INC, 1024, 4096, 2, (bf16_t*)(ws + WS_WIN), 1024)
        TJ_JOB(a.in[I_WGATE] + (size_t)l * 1024 * 3072, 3072, 1024, 3072, 0, (bf16_t*)(ws + WS_WG), 1024)
        TJ_JOB(a.in[I_WBR] + (size_t)(l * 3 + 0) * 512 * 1024, 1024, 512, 1024, 0, (bf16_t*)(ws + WS_WB) + (size_t)0 * 1024 * 512, 512)
        TJ_JOB(a.in[I_WBR] + (size_t)(l * 3 + 1) * 512 * 1024, 1024, 512, 1024, 0, (bf16_t*)(ws + WS_WB) + (size_t)1 * 1024 * 512, 512)
        TJ_JOB(a.in[I_WBR] + (size_t)(l * 3 + 2) * 512 * 1024, 1024, 512, 1024, 0, (bf16_t*)(ws + WS_WB) + (size_t)2 * 1024 * 512, 512)
        TJ_JOB(a.in[I_WOUT] + (size_t)l * 1024 * 1024, 1024, 1024, 1024, 0, (bf16_t*)(ws + WS_WO3), 1024)
        TJ_JOB(a.in[I_CW1] + (size_t)(l * 2 + 0) * 2048 * 128, 128, 1024, 128, 0, (bf16_t*)(ws + WS_WC1), 1024)
        TJ_JOB(a.in[I_CW1] + (size_t)(l * 2 + 0) * 2048 * 128 + (size_t)1024 * 128, 128, 1024, 128, 0, (bf16_t*)(ws + WS_WC1) + (size_t)128 * 1024, 1024)
        TJ_JOB(a.in[I_CW1] + (size_t)(l * 2 + 1) * 2048 * 128, 128, 1024, 128, 0, (bf16_t*)(ws + WS_WC1) + (size_t)256 * 1024, 1024)
        TJ_JOB(a.in[I_CW1] + (size_t)(l * 2 + 1) * 2048 * 128 + (size_t)1024 * 128, 128, 1024, 128, 0, (bf16_t*)(ws + WS_WC1) + (size_t)256 * 1024 + (size_t)128 * 1024, 1024)
        transpose_tile(jb, tt, tl, otid);
    }
    const int kvb = (int)blockIdx.x - ((int)gridDim.x - 32);
    if (kvb >= 0) {
        const int kv = kvb >> 4, h0 = (kvb & 15) * 8, hh = otid & 7, ks = otid >> 3;
        const float* pe = a.in[I_PE] + (size_t)(l * 2 + kv) * 2048 + ks * 32; const float* w1 = a.in[I_CW1] + (size_t)(l * 2 + kv) * 2048 * 128 + (size_t)ks * 32 * 128 + h0 + hh;
        float s = 0.f;
#pragma unroll 8
        for (int k = 0; k < 32; ++k) s += pe[k] * w1[(size_t)k * 128];
        __syncthreads();
        tl[otid] = s;
        __syncthreads();
        if (otid < 8) { float t = 0.f; for (int q = 0; q < 64; ++q) t += tl[q * 8 + otid]; ((float*)(ws + WS_CB1))[kv * 128 + h0 + otid] = t; }
        __syncthreads();
    }
}

__device__ __forceinline__ void mod_rope_phase(const Args& a, LAS unsigned char* lds) {
    const int otid = opaque_tid();
    LAS float* sc = (LAS float*)lds;
    LAS float* red = (LAS float*)(lds + 32768);
    const int tid = otid, lane = tid & 63, w = tid >> 6;
    for (int i = tid; i < 8192; i += NTHR) { const float v = a.in[I_C][i]; sc[i] = v / (1.f + __expf(-v)); }
    __syncthreads();
    float* MOD = (float*)(a.ws + WS_MOD);
    for (int u = blockIdx.x; u < 288; u += gridDim.x) {
        const int l = u / 144, j0 = (u % 144) * 64;
        const float* mw = a.in[I_MODW] + (size_t)l * 1024 * 9216 + j0 + lane;
        float acc[8];
#pragma unroll
        for (int b = 0; b < 8; ++b) acc[b] = 0.f;
        for (int k = w * 128; k < w * 128 + 128; k += 16) {
            float wv[16];
#pragma unroll
            for (int q = 0; q < 16; ++q) wv[q] = mw[(size_t)(k + q) * 9216];
#pragma unroll
            for (int q = 0; q < 16; ++q)
#pragma unroll
                for (int b = 0; b < 8; ++b) acc[b] += sc[b * 1024 + k + q] * wv[q];
        }
#pragma unroll
        for (int b = 0; b < 8; ++b) red[(w * 8 + b) * 64 + lane] = acc[b];
        __syncthreads();
        {
            const int b = w; float s = 0.f;
#pragma unroll
            for (int sl = 0; sl < 8; ++sl) s += red[(sl * 8 + b) * 64 + lane];
            MOD[(size_t)(l * 8 + b) * 9216 + j0 + lane] = s + a.in[I_MODB][l * 9216 + j0 + lane];
        }
        __syncthreads();
    }
    float* RT = (float*)(a.ws + WS_ROPE);
    for (int i = blockIdx.x * NTHR + tid; i < 4096 * 8; i += gridDim.x * NTHR) {
        const int s = i >> 3, e = i & 7;
        const float inv = 1.0f / powf(500000.0f, (float)(2 * e) / 16.0f);
        const float ang = (float)s * inv;
        RT[i * 2] = cosf(ang); RT[i * 2 + 1] = sinf(ang);
    }
}

__device__ __forceinline__ u32x2 pack4(f32x4 v) { u32x2 o; o.x = cvt_pk_bf16(v[0], v[1]); o.y = cvt_pk_bf16(v[2], v[3]); return o; }
struct NormRows { f32x4 xv[2][4]; u32x2 yr[2][4]; };
__device__ __forceinline__ void norm_load(NormRows& R, const void* xin, bool xin_bf, const bf16_t* y, int r, int lane) {
#pragma unroll
    for (int q = 0; q < 2; ++q)
#pragma unroll
        for (int s = 0; s < 4; ++s) {
            const size_t e = (size_t)(r + q) * DM + s * 256 + lane * 4;
            if (xin_bf) { const u32x2 t = __builtin_nontemporal_load((const u32x2*)((const bf16_t*)xin + e));
                R.xv[q][s] = (f32x4){__uint_as_float(t.x << 16), __uint_as_float(t.x & 0xffff0000u), __uint_as_float(t.y << 16), __uint_as_float(t.y & 0xffff0000u)}; }
            else R.xv[q][s] = __builtin_nontemporal_load((const f32x4*)((const float*)xin + e));
            if (y) R.yr[q][s] = __builtin_nontemporal_load((const u32x2*)(y + e));
        }
}
__device__ __forceinline__ void norm_rows(NormRows& R, bool hasy, const f32x4 (&gp)[4], const f32x4 (&pa)[4], const float* mshift, int b, void* xout, bool xout_bf, bf16_t* h, int r, int lane) {
    if (hasy) {
        float ss[2];
#pragma unroll
        for (int q = 0; q < 2; ++q) { float t = 0.f;
#pragma unroll
            for (int s = 0; s < 4; ++s) { const float a0 = __uint_as_float(R.yr[q][s].x << 16), a1 = __uint_as_float(R.yr[q][s].x & 0xffff0000u), a2 = __uint_as_float(R.yr[q][s].y << 16), a3 = __uint_as_float(R.yr[q][s].y & 0xffff0000u);
                t += a0 * a0 + a1 * a1 + a2 * a2 + a3 * a3; }
            ss[q] = t; }
#pragma unroll
        for (int o = 32; o >= 1; o >>= 1)
#pragma unroll
            for (int q = 0; q < 2; ++q) ss[q] += __shfl_xor(ss[q], o);
#pragma unroll
        for (int q = 0; q < 2; ++q) { const float rs = rsqrtf(ss[q] * (1.f / DM) + 1e-6f);
#pragma unroll
            for (int s = 0; s < 4; ++s) { const f32x4 yv = (f32x4){__uint_as_float(R.yr[q][s].x << 16), __uint_as_float(R.yr[q][s].x & 0xffff0000u), __uint_as_float(R.yr[q][s].y << 16), __uint_as_float(R.yr[q][s].y & 0xffff0000u)};
                R.xv[q][s] += gp[s] * (yv * rs);
                const size_t e = (size_t)(r + q) * DM + s * 256 + lane * 4;
                if (xout_bf) { const u32x2 pk = pack4(R.xv[q][s]); *(u32x2*)((bf16_t*)xout + e) = pk;
                    R.xv[q][s] = (f32x4){__uint_as_float(pk.x << 16), __uint_as_float(pk.x & 0xffff0000u), __uint_as_float(pk.y << 16), __uint_as_float(pk.y & 0xffff0000u)}; }
                else *(f32x4*)((float*)xout + e) = R.xv[q][s]; } }
    }
    if (h) {
        float ss[2]; f32x4 ps[4];
#pragma unroll
        for (int s = 0; s < 4; ++s) ps[s] = *(const f32x4*)(mshift + b * 9216 + s * 256 + lane * 4);
#pragma unroll
        for (int q = 0; q < 2; ++q) { float t = 0.f;
#pragma unroll
            for (int s = 0; s < 4; ++s) { const f32x4 v = R.xv[q][s]; t += v[0] * v[0] + v[1] * v[1] + v[2] * v[2] + v[3] * v[3]; }
            ss[q] = t; }
#pragma unroll
        for (int o = 32; o >= 1; o >>= 1)
#pragma unroll
            for (int q = 0; q < 2; ++q) ss[q] += __shfl_xor(ss[q], o);
#pragma unroll
        for (int q = 0; q < 2; ++q) { const float rs = rsqrtf(ss[q] * (1.f / DM) + 1e-6f);
#pragma unroll
            for (int s = 0; s < 4; ++s) { const f32x4 o = R.xv[q][s] * rs * pa[s] + ps[s];
                *(u32x2*)(h + (size_t)(r + q) * DM + s * 256 + lane * 4) = pack4(o); } }
    }
}
__device__ __forceinline__ void norm_phase(const void* xin, bool xin_bf, const bf16_t* y, const float* gpost, const float* mgate, float rw,
                                           const float* gpre, const float* mshift, const float* mscale, void* xout, bool xout_bf, bf16_t* h) {
    const int otid = opaque_tid();
    const int lane = otid & 63, w = otid >> 6;
    const int nw = gridDim.x * 8, rows_per = NTOK / nw;
    const int gw = blockIdx.x * 8 + w;
    const int r0 = gw * rows_per, b = r0 / SQ;
    f32x4 gp[4], pa[4];
#pragma unroll
    for (int s = 0; s < 4; ++s) {
        const int c = s * 256 + lane * 4;
        if (y) { const f32x4 g1 = *(const f32x4*)(mgate + b * 9216 + c), g2 = *(const f32x4*)(gpost + c); gp[s] = g1 * g2 * rw; } else gp[s] = (f32x4){0.f, 0.f, 0.f, 0.f};
        if (h) { const f32x4 g1 = *(const f32x4*)(gpre + c), g2 = *(const f32x4*)(mscale + b * 9216 + c); pa[s] = g1 * (g2 + 1.f); }
        else { pa[s] = (f32x4){0.f, 0.f, 0.f, 0.f}; }
    }
    NormRows A, B;
    norm_load(A, xin, xin_bf, y, r0, lane);
    for (int r = r0; r < r0 + rows_per; r += 4) {
        norm_load(B, xin, xin_bf, y, r + 2, lane);
        norm_rows(A, y != nullptr, gp, pa, mshift, b, xout, xout_bf, h, r, lane);
        if (r + 4 < r0 + rows_per) norm_load(A, xin, xin_bf, y, r + 4, lane);
        norm_rows(B, y != nullptr, gp, pa, mshift, b, xout, xout_bf, h, r + 2, lane);
    }
}

#define EPI8(...) \
    _Pragma("unroll") for (int ai = 0; ai < 2; ++ai) _Pragma("unroll") for (int m = 0; m < 4; ++m) { const int row = u.pm * 256 + ai * 128 + wr * 64 + m * 16 + fr; \
    _Pragma("unroll") for (int bj = 0; bj < 2; ++bj) { const int c8 = bj * 128 + wc * 32 + fq * 8; const f32x4 v0 = acc[ai][bj][m][0], v1 = acc[ai][bj][m][1]; __VA_ARGS__ } }
__device__ __forceinline__ u32x4v pack8(f32x4 a, f32x4 b) { u32x4v o; o.x = cvt_pk_bf16(a[0], a[1]); o.y = cvt_pk_bf16(a[2], a[3]); o.z = cvt_pk_bf16(b[0], b[1]); o.w = cvt_pk_bf16(b[2], b[3]); return o; }
__device__ __forceinline__ f32x4 unlo(u32x4v g) { return (f32x4){__uint_as_float(g.x << 16), __uint_as_float(g.x & 0xffff0000u), __uint_as_float(g.y << 16), __uint_as_float(g.y & 0xffff0000u)}; }
__device__ __forceinline__ f32x4 unhi(u32x4v g) { return (f32x4){__uint_as_float(g.z << 16), __uint_as_float(g.z & 0xffff0000u), __uint_as_float(g.w << 16), __uint_as_float(g.w & 0xffff0000u)}; }
__device__ __forceinline__ f32x4 sig4(f32x4 v) { return (f32x4){sigm(v[0]), sigm(v[1]), sigm(v[2]), sigm(v[3])}; }
__device__ __forceinline__ f32x4 gelu4(f32x4 v) { return (f32x4){gelu_t(v[0]), gelu_t(v[1]), gelu_t(v[2]), gelu_t(v[3])}; }

struct EpiPlain {
    static constexpr bool PERM = true, AFTER_DRAIN = false;
    bf16_t* O; int ldc;
    __device__ __forceinline__ void operator()(const f32x4 (&acc)[2][2][4][2], const pg8::Unit& u, int wr, int wc, int fr, int fq) const {
        EPI8( *(u32x4v*)(O + (size_t)row * ldc + u.pn * 256 + c8) = pack8(v0, v1); )
    }
};
struct EpiSigmoid {
    static constexpr bool PERM = true, AFTER_DRAIN = false;
    bf16_t* O; int ldc;
    __device__ __forceinline__ void operator()(const f32x4 (&acc)[2][2][4][2], const pg8::Unit& u, int wr, int wc, int fr, int fq) const {
        EPI8( *(u32x4v*)(O + (size_t)row * ldc + u.pn * 256 + c8) = pack8(sig4(v0), sig4(v1)); )
    }
};
struct EpiBranchAcc {
    static constexpr bool PERM = true, AFTER_DRAIN = false;
    const bf16_t* G; bf16_t* Mg;
    __device__ __forceinline__ void operator()(const f32x4 (&acc)[2][2][4][2], const pg8::Unit& u, int wr, int wc, int fr, int fq) const {
        const int nb = u.pn >> 2, dt = u.pn & 3;
#pragma unroll
        for (int ai = 0; ai < 2; ++ai) {
            u32x4v gv[4][2], qv[4][2];
#pragma unroll
            for (int m = 0; m < 4; ++m)
#pragma unroll
                for (int bj = 0; bj < 2; ++bj) {
                    const int row = u.pm * 256 + ai * 128 + wr * 64 + m * 16 + fr, c8 = bj * 128 + wc * 32 + fq * 8;
                    gv[m][bj] = *(const u32x4v*)(G + (size_t)row * 3072 + nb * 1024 + dt * 256 + c8);
                    if (nb > 0) qv[m][bj] = *(const u32x4v*)(Mg + (size_t)row * 1024 + dt * 256 + c8); else qv[m][bj] = (u32x4v){0u, 0u, 0u, 0u};
                }
#pragma unroll
            for (int m = 0; m < 4; ++m)
#pragma unroll
                for (int bj = 0; bj < 2; ++bj) {
                    const int row = u.pm * 256 + ai * 128 + wr * 64 + m * 16 + fr, c8 = bj * 128 + wc * 32 + fq * 8;
                    f32x4 o0 = acc[ai][bj][m][0] * unlo(gv[m][bj]), o1 = acc[ai][bj][m][1] * unhi(gv[m][bj]);
                    if (nb > 0) { o0 += unlo(qv[m][bj]); o1 += unhi(qv[m][bj]); }
                    *(u32x4v*)(Mg + (size_t)row * 1024 + dt * 256 + c8) = pack8(o0, o1);
                }
        }
    }
};
struct BranchOrder {
    pg8::StaticOrder S4;
    __device__ void init(int M, int G_, int c_) { S4.init(M, 1024, G_, c_); }
    __device__ bool next(int i, pg8::Unit& u) const { const int j = i / 3, n = i - 3 * j; pg8::Unit t; if (!S4.next(j, t)) return false; u.pm = t.pm; u.pn = n * 4 + t.pn; return true; }
    __device__ __forceinline__ void a_ready(const pg8::Unit&) const {}
    __device__ __forceinline__ void done(const pg8::Unit&) const {}
};
struct EpiSwiglu {
    static constexpr bool PERM = true, AFTER_DRAIN = false;
    bf16_t* O;
    __device__ __forceinline__ void operator()(const f32x4 (&acc)[2][2][4][2], const pg8::Unit& u, int wr, int wc, int fr, int fq) const {
#pragma unroll
        for (int ai = 0; ai < 2; ++ai)
#pragma unroll
            for (int m = 0; m < 4; ++m) { const int row = u.pm * 256 + ai * 128 + wr * 64 + m * 16 + fr;
                f32x4 o[2];
#pragma unroll
                for (int n = 0; n < 2; ++n) { const f32x4 g = acc[ai][0][m][n], uu = acc[ai][1][m][n];
#pragma unroll
                    for (int j = 0; j < 4; ++j) o[n][j] = g[j] * sigm(g[j]) * uu[j]; }
                *(u32x4v*)(O + (size_t)row * DFF + u.pn * 128 + wc * 32 + fq * 8) = pack8(o[0], o[1]); }
    }
};
struct EpiWin {
    static constexpr bool PERM = true, AFTER_DRAIN = false;
    bf16_t* AIN; bf16_t* Q; bf16_t* KV; bf16_t* C; float* NG;
    __device__ __forceinline__ void operator()(const f32x4 (&acc)[2][2][4][2], const pg8::Unit& u, int wr, int wc, int fr, int fq) const {
        const int pn = u.pn;
        if (pn < 4) { EPI8( *(u32x4v*)(AIN + (size_t)row * 1024 + pn * 256 + c8) = pack8(gelu4(v0), gelu4(v1)); ) }
        else if (pn < 6) { EPI8( *(u32x4v*)(Q + (size_t)row * 512 + (pn - 4) * 256 + c8) = pack8(v0, v1); ) }
        else if (pn < 9) { EPI8( const int cc = (pn - 6) * 256 + c8; const int which = cc >> 7, g = (cc >> 6) & 1, d = cc & 63; const int b = row >> 12, s = row & 4095;
                                 *(u32x4v*)(KV + (size_t)which * KVSZ + ((size_t)(b * 2 + g) * 4096 + s) * 64 + d) = pack8(v0, v1); ) }
        else if (pn < 15) { EPI8( *(u32x4v*)(C + (size_t)row * 1536 + (pn - 9) * 256 + c8) = pack8(v0, v1); ) }
        else { EPI8( if (c8 < 24) { *(f32x4*)(NG + (size_t)row * 24 + c8) = v0; *(f32x4*)(NG + (size_t)row * 24 + c8 + 4) = v1; } ) }
    }
};
struct EpiUL {
    static constexpr bool PERM = true, AFTER_DRAIN = false;
    float* O;
    __device__ __forceinline__ void operator()(const f32x4 (&acc)[2][2][4][2], const pg8::Unit& u, int wr, int wc, int fr, int fq) const {
        EPI8( *(f32x4*)(O + (size_t)row * 256 + c8) = v0; *(f32x4*)(O + (size_t)row * 256 + c8 + 4) = v1; )
    }
};
struct EpiCmp1 {
    static constexpr bool PERM = true, AFTER_DRAIN = false;
    bf16_t* O; const float* cb;
    __device__ __forceinline__ void operator()(const f32x4 (&acc)[2][2][4][2], const pg8::Unit& u, int wr, int wc, int fr, int fq) const {
        EPI8( if (bj == 0) { const f32x4 b0 = *(const f32x4*)(cb + c8), b1 = *(const f32x4*)(cb + c8 + 4);
              *(u32x4v*)(O + (size_t)row * 128 + c8) = pack8(gelu4(v0 + b0), gelu4(v1 + b1)); } )
    }
};

template <class Epi> __device__ __forceinline__ void run_gemm(LAS unsigned char* lds, const bf16_t* A, int lda, const bf16_t* Bt, int ldb, int M, int N, int K, int adiv, int aoff, const Epi& E, int cshift = 0) {
    pg8::Gemm g; g.A = A; g.Bt = Bt; g.M = M; g.N = N; g.K = K; g.lda = lda; g.ldb = ldb; g.adiv = adiv; g.aoff = aoff;
    pg8::StaticOrder S; S.init(M, N, (int)gridDim.x, (int)((blockIdx.x + cshift) % gridDim.x));
    pg8::gemm_phase<Epi, pg8::StaticOrder, true, true>((PG8_LAS unsigned char*)lds, g, S, E);
    __syncthreads();
}

__device__ __forceinline__ void gmlp_phase(const Args& a, int l, LAS unsigned char* lds) {
    const int otid = opaque_tid();
    const bf16_t* AIN = (const bf16_t*)(a.ws + WS_R1 + R1_AIN);
    bf16_t* YS = (bf16_t*)(a.ws + WS_R2);
    LAS bf16_t* Vt = (LAS bf16_t*)lds;
    const int tid = otid, lane = tid & 63, w = tid >> 6, fr = lane & 15, fq = lane >> 4;
    const float* lng = a.in[I_LNG] + l * 512; const float* lnb = a.in[I_LNB] + l * 512;
    const int bx = (int)blockIdx.x; const bool g256 = gridDim.x == 256;
    const bool cmpblk = g256 && ((bx >= 64 && bx < 80) || (bx >= 192 && bx < 208));
    const int extra = !g256 ? -1 : (bx < 16 ? 64 + bx : ((bx >= 128 && bx < 144) ? 192 + (bx - 128) : -1));
    const int nit = (256 - bx + (int)gridDim.x - 1) / (int)gridDim.x;
    for (int ii = 0; ii < nit; ++ii) {
        const int it = bx + ii * (int)gridDim.x;
        const int row0 = it * 128;
        __syncthreads();
        for (int s8 = w * 16; s8 < w * 16 + 16; s8 += 8) {
            float x[8][8]; float sm[8], sq[8];
#pragma unroll
            for (int q = 0; q < 8; ++q) { const bf16_t* vp = AIN + (size_t)(row0 + s8 + q) * 1024 + 512;
#pragma unroll
                for (int e = 0; e < 8; ++e) x[q][e] = bf2f(vp[lane + 64 * e]); }
#pragma unroll
            for (int q = 0; q < 8; ++q) { float t = 0.f;
#pragma unroll
                for (int e = 0; e < 8; ++e) t += x[q][e];
                sm[q] = t; }
#pragma unroll
            for (int o = 32; o >= 1; o >>= 1)
#pragma unroll
                for (int q = 0; q < 8; ++q) sm[q] += __shfl_xor(sm[q], o);
#pragma unroll
            for (int q = 0; q < 8; ++q) { const float mu = sm[q] * (1.f / 512.f); sm[q] = mu; float t = 0.f;
#pragma unroll
                for (int e = 0; e < 8; ++e) { const float d = x[q][e] - mu; t += d * d; }
                sq[q] = t; }
#pragma unroll
            for (int o = 32; o >= 1; o >>= 1)
#pragma unroll
                for (int q = 0; q < 8; ++q) sq[q] += __shfl_xor(sq[q], o);
#pragma unroll
            for (int e = 0; e < 8; ++e) { const int c = lane + 64 * e; const float lg = lng[c], lb = lnb[c];
#pragma unroll
                for (int q = 0; q < 8; ++q) { const float rstd = rsqrtf(sq[q] * (1.f / 512.f) + 1e-6f); Vt[c * 136 + s8 + q] = f2bf((x[q][e] - sm[q]) * rstd * lg + lb); } }
        }
        __syncthreads();
        const int g = w >> 1, jw = w & 1;
        const float* W = a.in[I_GWS] + (size_t)(l * 4 + g) * 128 * 128;
        for (int tix = 0; tix < 4; ++tix) {
            const int T = jw == 0 ? (tix == 0 ? 0 : (tix == 1 ? 7 : (tix == 2 ? 2 : 5))) : (tix == 0 ? 1 : (tix == 1 ? 6 : (tix == 2 ? 3 : 4)));
            const int t0 = T * 16, t = t0 + fr, nkk = (T >> 1) + 1;
            const size_t row = (size_t)(row0 + t);
            f32x4 wl[4][2]; u32x2 uv[8];
#pragma unroll
            for (int kk = 0; kk < 4; ++kk) { if (kk < nkk) { wl[kk][0] = *(const f32x4*)(W + t * 128 + kk * 32 + fq * 8); wl[kk][1] = *(const f32x4*)(W + t * 128 + kk * 32 + fq * 8 + 4); }
                else { wl[kk][0] = (f32x4){0.f, 0.f, 0.f, 0.f}; wl[kk][1] = wl[kk][0]; } }
#pragma unroll
            for (int c = 0; c < 8; ++c) uv[c] = *(const u32x2*)(AIN + row * 1024 + g * 128 + c * 16 + fq * 4);
            const float bias = a.in[I_GBS][(l * 4 + g) * 128 + t];
            f32x4 acc[8];
#pragma unroll
            for (int c = 0; c < 8; ++c) acc[c] = (f32x4){0.f, 0.f, 0.f, 0.f};
#pragma unroll
            for (int kk = 0; kk < 4; ++kk) {
                if (kk < nkk) {
                    const int s0 = kk * 32 + fq * 8;
                    float wv[8] = {wl[kk][0][0], wl[kk][0][1], wl[kk][0][2], wl[kk][0][3], wl[kk][1][0], wl[kk][1][1], wl[kk][1][2], wl[kk][1][3]};
#pragma unroll
                    for (int e = 0; e < 8; ++e) wv[e] = (s0 + e <= t) ? wv[e] : 0.f;
                    u32x4v wp; wp.x = cvt_pk_bf16(wv[0], wv[1]); wp.y = cvt_pk_bf16(wv[2], wv[3]); wp.z = cvt_pk_bf16(wv[4], wv[5]); wp.w = cvt_pk_bf16(wv[6], wv[7]);
                    const bf16x8 Wf = __builtin_bit_cast(bf16x8, wp);
#pragma unroll
                    for (int c = 0; c < 8; ++c) {
                        const bf16x8 Af = *(const LAS bf16x8*)(Vt + (g * 128 + c * 16 + fr) * 136 + kk * 32 + fq * 8);
                        acc[c] = __builtin_amdgcn_mfma_f32_16x16x32_bf16(Af, Wf, acc[c], 0, 0, 0);
                    }
                }
            }
#pragma unroll
            for (int c = 0; c < 8; ++c) {
                const int col = g * 128 + c * 16 + fq * 4;
                f32x4 o;
                o[0] = __uint_as_float(uv[c].x << 16) * (acc[c][0] + bias); o[1] = __uint_as_float(uv[c].x & 0xffff0000u) * (acc[c][1] + bias);
                o[2] = __uint_as_float(uv[c].y << 16) * (acc[c][2] + bias); o[3] = __uint_as_float(uv[c].y & 0xffff0000u) * (acc[c][3] + bias);
                *(u32x2*)(YS + row * 1536 + col) = pack4(o);
            }
        }
    }
    __syncthreads();
}

__device__ __forceinline__ void conv_rope_phase(const Args& a, int l, bool do_rope) {
    const int otid = opaque_tid();
    const bf16_t* C = (const bf16_t*)(a.ws + WS_R1 + R1_C);
    bf16_t* YS = (bf16_t*)(a.ws + WS_R2);
    const float* cw = a.in[I_CONVW] + (size_t)l * 3 * 512;
    const int gt = blockIdx.x * NTHR + otid, gn = gridDim.x * NTHR;
    const int bx = (int)blockIdx.x; const bool g256 = gridDim.x == 256;
    const bool cmpblk = g256 && ((bx & 63) < 16);
    const int vb = !g256 ? bx : (bx >> 6) * 48 + (bx & 63) - 16;
    const int cgt = vb * NTHR + otid, cgn = (g256 ? 192 : (int)gridDim.x) * NTHR;
    for (int i = cmpblk ? (NTOK / 4) * 64 : cgt; i < (NTOK / 4) * 64; i += cgn) {
        const int r0 = (i >> 6) * 4, c0 = (i & 63) * 8, s0 = r0 & 4095;
        u32x4v cgv[6], xtv[6], bgv[4];
#pragma unroll
        for (int k = 0; k < 6; ++k) {
            if (k >= 2 || s0 > 0) { const bf16_t* p = C + (size_t)(r0 - 2 + k) * 1536; cgv[k] = *(const u32x4v*)(p + 512 + c0); xtv[k] = *(const u32x4v*)(p + 1024 + c0); }
            else { cgv[k] = (u32x4v){0u, 0u, 0u, 0u}; xtv[k] = cgv[k]; }
        }
#pragma unroll
        for (int q = 0; q < 4; ++q) bgv[q] = *(const u32x4v*)(C + (size_t)(r0 + q) * 1536 + c0);
        float w0[8], w1[8], w2[8];
#pragma unroll
        for (int e = 0; e < 8; ++e) { w0[e] = cw[c0 + e]; w1[e] = cw[512 + c0 + e]; w2[e] = cw[1024 + c0 + e]; }
        float hc[6][8];
#pragma unroll
        for (int k = 0; k < 6; ++k) {
            const unsigned cgw[4] = {cgv[k].x, cgv[k].y, cgv[k].z, cgv[k].w}, xtw[4] = {xtv[k].x, xtv[k].y, xtv[k].z, xtv[k].w};
#pragma unroll
            for (int e = 0; e < 4; ++e) { hc[k][2 * e] = __uint_as_float(cgw[e] << 16) * __uint_as_float(xtw[e] << 16); hc[k][2 * e + 1] = __uint_as_float(cgw[e] & 0xffff0000u) * __uint_as_float(xtw[e] & 0xffff0000u); }
        }
#pragma unroll
        for (int q = 0; q < 4; ++q) {
            const unsigned bgw[4] = {bgv[q].x, bgv[q].y, bgv[q].z, bgv[q].w};
            float o[8];
#pragma unroll
            for (int e = 0; e < 8; ++e) {
                const float bv = (e & 1) ? __uint_as_float(bgw[e >> 1] & 0xffff0000u) : __uint_as_float(bgw[e >> 1] << 16);
                o[e] = bv * (w0[e] * hc[q][e] + w1[e] * hc[q + 1][e] + w2[e] * hc[q + 2][e]);
            }
            u32x4v w; w.x = cvt_pk_bf16(o[0], o[1]); w.y = cvt_pk_bf16(o[2], o[3]); w.z = cvt_pk_bf16(o[4], o[5]); w.w = cvt_pk_bf16(o[6], o[7]);
            *(u32x4v*)(YS + (size_t)(r0 + q) * 1536 + 1024 + c0) = w;
        }
    }
    bf16_t* KV = (bf16_t*)(a.ws + WS_R1 + R1_KV);
    const float* RT = (const float*)(a.ws + WS_ROPE);
    if (do_rope) for (int i = gt; i < 2 * 16 * 4096; i += gn) {
        const int wsel = i >> 16, rem = i & 65535, s = rem & 4095;
        bf16_t* p = KV + (size_t)(wsel ? 4 : 2) * KVSZ + (size_t)rem * 64;
        const u32x4v x1 = *(const u32x4v*)p, x2 = *(const u32x4v*)(p + 8);
        const unsigned a1[4] = {x1.x, x1.y, x1.z, x1.w}, a2[4] = {x2.x, x2.y, x2.z, x2.w};
        float r1[8], r2[8];
#pragma unroll
        for (int e = 0; e < 8; ++e) {
            const float v1 = (e & 1) ? __uint_as_float(a1[e >> 1] & 0xffff0000u) : __uint_as_float(a1[e >> 1] << 16);
            const float v2 = (e & 1) ? __uint_as_float(a2[e >> 1] & 0xffff0000u) : __uint_as_float(a2[e >> 1] << 16);
            const float cs = RT[(s * 8 + e) * 2], sn = RT[(s * 8 + e) * 2 + 1];
            r1[e] = v1 * cs - v2 * sn; r2[e] = v2 * cs + v1 * sn;
        }
        u32x4v o1, o2;
        o1.x = cvt_pk_bf16(r1[0], r1[1]); o1.y = cvt_pk_bf16(r1[2], r1[3]); o1.z = cvt_pk_bf16(r1[4], r1[5]); o1.w = cvt_pk_bf16(r1[6], r1[7]);
        o2.x = cvt_pk_bf16(r2[0], r2[1]); o2.y = cvt_pk_bf16(r2[2], r2[3]); o2.z = cvt_pk_bf16(r2[4], r2[5]); o2.w = cvt_pk_bf16(r2[6], r2[7]);
        *(u32x4v*)p = o1; *(u32x4v*)(p + 8) = o2;
    }
}

__device__ __forceinline__ void cmp2_phase(const Args& a, int l, LAS unsigned char* lds) {
    const int otid = opaque_tid();
    const int lane = otid & 63, w = otid >> 6;
    const float* UL = (const float*)(a.ws + WS_UL);
    const float* CB = (const float*)(a.ws + WS_CB1);
    bf16_t* KC = (bf16_t*)(a.ws + WS_KC);
    LAS float* hb = (LAS float*)lds + w * 512;
    const int nw = gridDim.x * 8;
    const int wv = blockIdx.x * 8 + w;
    if (nw == 2048) {
#pragma unroll
        for (int q = 0; q < 4; ++q) {
            const int rr = wv + q * 2048, kv = rr >> 12, r = rr & 4095, r1 = r + 1 > 4095 ? 4095 : r + 1;
            const float* U = UL + ((size_t)kv * 4096 + r) * 256; const float* L = UL + ((size_t)kv * 4096 + r1) * 256 + 128;
            const size_t P1 = (size_t)2 * 4096 * 256;
            hb[q * 128 + lane] = gelu_t((U[lane] + U[P1 + lane]) + (L[lane] + L[P1 + lane]) + CB[kv * 128 + lane]);
            hb[q * 128 + lane + 64] = gelu_t((U[lane + 64] + U[P1 + lane + 64]) + (L[lane + 64] + L[P1 + lane + 64]) + CB[kv * 128 + lane + 64]);
        }
        __syncthreads();
        const float* w2a = a.in[I_CW2] + (size_t)(l * 2 + 0) * 128 * 64 + lane; const float* w2b = a.in[I_CW2] + (size_t)(l * 2 + 1) * 128 * 64 + lane;
        float s0 = 0.f, s1 = 0.f, s2 = 0.f, s3 = 0.f;
#pragma unroll 16
        for (int h = 0; h < 128; ++h) { const float wa = w2a[h * 64], wb = w2b[h * 64]; s0 += hb[h] * wa; s1 += hb[128 + h] * wa; s2 += hb[256 + h] * wb; s3 += hb[384 + h] * wb; }
        KC[(size_t)(wv) * 64 + lane] = f2bf(s0); KC[(size_t)(wv + 2048) * 64 + lane] = f2bf(s1); KC[(size_t)(wv + 4096) * 64 + lane] = f2bf(s2); KC[(size_t)(wv + 6144) * 64 + lane] = f2bf(s3);
        __syncthreads();
    } else {
        for (int rr = wv; rr < 2 * 4096; rr += nw) {
            const int kv = rr >> 12, r = rr & 4095, r1 = r + 1 > 4095 ? 4095 : r + 1;
            const float* U = UL + ((size_t)kv * 4096 + r) * 256; const float* L = UL + ((size_t)kv * 4096 + r1) * 256 + 128;
            const float* w2 = a.in[I_CW2] + (size_t)(l * 2 + kv) * 128 * 64 + lane;
            float s0 = 0.f;
            for (int h = 0; h < 128; ++h) s0 += gelu_t((U[h] + U[(size_t)2 * 4096 * 256 + h]) + (L[h] + L[(size_t)2 * 4096 * 256 + h]) + CB[kv * 128 + h]) * w2[h * 64];
            KC[(size_t)rr * 64 + lane] = f2bf(s0);
        }
    }
}

constexpr int KSTR = 72;
enum { M_CMP1 = 0, M_CMP2 = 1, M_SLC = 2, M_WIN = 3 };

struct AttnState {
    bf16x8 qf[2][2];
    float m[2], l[2];
    f32x4 o[2][4];
};

constexpr float ATT_THR = 6.0f;
constexpr float ATT_QS = 0.125f * 1.4426950408889634f;

typedef short s16x4 __attribute__((ext_vector_type(4)));
__device__ __forceinline__ void attn_vload(bf16x8 (&vf)[2][4], const LAS bf16_t* Vt, int fr, int fq) {
    const LAS bf16_t* vb = Vt + (4 * fq + (fr >> 2)) * KSTR + 4 * (fr & 3);
#pragma unroll
    for (int kg = 0; kg < 2; ++kg)
#pragma unroll
        for (int dt = 0; dt < 4; ++dt) {
            const s16x4 v0 = __builtin_amdgcn_ds_read_tr16_b64_v4i16((LAS s16x4*)(vb + (kg * 32) * KSTR + dt * 16));
            const s16x4 v1 = __builtin_amdgcn_ds_read_tr16_b64_v4i16((LAS s16x4*)(vb + (kg * 32 + 16) * KSTR + dt * 16));
            vf[kg][dt] = (bf16x8){v0[0], v0[1], v0[2], v0[3], v1[0], v1[1], v1[2], v1[3]};
        }
}
__device__ __forceinline__ void attn_pvr(AttnState& st, const bf16x8 (&vf)[2][4], const bf16x8 (&pf)[2][2]) {
#pragma unroll
    for (int kg = 0; kg < 2; ++kg)
#pragma unroll
        for (int dt = 0; dt < 4; ++dt)
#pragma unroll
            for (int ct = 0; ct < 2; ++ct) st.o[ct][dt] = __builtin_amdgcn_mfma_f32_16x16x32_bf16(vf[kg][dt], pf[kg][ct], st.o[ct][dt], 0, 0, 0);
}
__device__ __forceinline__ void attn_pv(AttnState& st, const LAS bf16_t* Vt, const bf16x8 (&pf)[2][2], int fr, int fq) {
    bf16x8 vf[2][4];
    attn_vload(vf, Vt, fr, fq);
    attn_pvr(st, vf, pf);
}

template <int MODE, bool FAST, bool DEFER>
__device__ __forceinline__ void attn_tile(AttnState& st, const LAS bf16_t* Ks, const LAS bf16_t* Vt, int jb, int tq, bool mybit, int fr, int fq, float (&imp)[16], float& prev_t3, bf16x8 (&pfo)[2][2]) {
    constexpr bool ISCMP = (MODE == M_CMP1 || MODE == M_CMP2);
    f32x4 s[2][4];
    f32x4 zinit[2];
#pragma unroll
    for (int ct = 0; ct < 2; ++ct) { const float nb_ = !FAST ? 0.f : ((MODE == M_SLC && !mybit) ? -1e30f : (st.m[ct] < -1e29f ? 0.f : -st.m[ct])); zinit[ct] = (f32x4){nb_, nb_, nb_, nb_}; }
#pragma unroll
    for (int sb = 0; sb < 4; ++sb) {
        const bf16x8 k0 = *(const LAS bf16x8*)(Ks + (sb * 16 + fr) * KSTR + fq * 8);
        const bf16x8 k1 = *(const LAS bf16x8*)(Ks + (sb * 16 + fr) * KSTR + 32 + fq * 8);
#pragma unroll
        for (int ct = 0; ct < 2; ++ct) {
            f32x4 z = zinit[ct];
            z = __builtin_amdgcn_mfma_f32_16x16x32_bf16(k0, st.qf[ct][0], z, 0, 0, 0);
            z = __builtin_amdgcn_mfma_f32_16x16x32_bf16(k1, st.qf[ct][1], z, 0, 0, 0);
            s[ct][sb] = ISCMP ? z * ATT_QS : z;
        }
    }
    bf16x8 vfe[2][4];
    if (MODE == M_SLC || MODE == M_WIN) attn_vload(vfe, Vt, fr, fq);
    unsigned vbits = 0;
    if (!FAST) {
#pragma unroll
        for (int sb = 0; sb < 4; ++sb)
#pragma unroll
            for (int j = 0; j < 4; ++j) {
                const int kidx = jb * 64 + sb * 16 + fq * 4 + j;
                bool v;
                if (ISCMP) v = (16 * kidx + 31 <= tq);
                else if (MODE == M_SLC) v = mybit && (kidx <= tq);
                else v = (kidx <= tq) && (tq - kidx < 512);
                vbits |= (v ? 1u : 0u) << (sb * 4 + j);
            }
    }
    if (MODE == M_CMP2) {
        f32x4 p[2][4];
#pragma unroll
        for (int ct = 0; ct < 2; ++ct) {
            const float il = st.l[ct] > 0.f ? 1.f / st.l[ct] : 0.f;
#pragma unroll
            for (int sb = 0; sb < 4; ++sb)
#pragma unroll
                for (int j = 0; j < 4; ++j) p[ct][sb][j] = ((vbits >> (sb * 4 + j)) & 1u) ? __builtin_amdgcn_exp2f(s[ct][sb][j] - st.m[ct]) * il : 0.f;
        }
        {
            bf16x8 pfc[2][2];
#pragma unroll
            for (int kg = 0; kg < 2; ++kg)
#pragma unroll
                for (int ct = 0; ct < 2; ++ct) { u32x4v w; w.x = cvt_pk_bf16(p[ct][2 * kg][0], p[ct][2 * kg][1]); w.y = cvt_pk_bf16(p[ct][2 * kg][2], p[ct][2 * kg][3]);
                    w.z = cvt_pk_bf16(p[ct][2 * kg + 1][0], p[ct][2 * kg + 1][1]); w.w = cvt_pk_bf16(p[ct][2 * kg + 1][2], p[ct][2 * kg + 1][3]); pfc[kg][ct] = __builtin_bit_cast(bf16x8, w); }
            attn_pv(st, Vt, pfc, fr, fq);
        }
        const int lane = fq * 16 + fr;
#pragma unroll
        for (int sb = 0; sb < 4; ++sb) {
            float A = (p[0][sb][0] + p[0][sb][1] + p[0][sb][2]) + (p[1][sb][0] + p[1][sb][1] + p[1][sb][2]);
            float B = p[0][sb][3] + p[1][sb][3];
            A += __shfl_xor(A, 8); B += __shfl_xor(B, 8);
            const float xa = __shfl(B, (lane + 48) & 63), xb = __shfl(prev_t3, (lane + 48) & 63);
            const float pv = fq == 0 ? xb : xa;
            const float ival = A + 0.5f * B + 0.5f * pv;
#pragma unroll
            for (int T = 0; T < 4; ++T) if (jb == T) imp[T * 4 + sb] = ival;
            prev_t3 = B;
        }
        return;
    }
    if (FAST) {
        float tz[2]; bool nd[2]; bool un[2];
#pragma unroll
        for (int ct = 0; ct < 2; ++ct) {
            float t = -1e30f;
#pragma unroll
            for (int sb = 0; sb < 4; ++sb)
#pragma unroll
                for (int j = 0; j < 4; ++j) t = fmaxf(t, s[ct][sb][j]);
            t = fmaxf(t, __shfl_xor(t, 16)); t = fmaxf(t, __shfl_xor(t, 32));
            tz[ct] = t; un[ct] = st.m[ct] < -1e29f;
            nd[ct] = (t > -1e29f) && (t > ATT_THR || un[ct]);
        }
        if (__builtin_amdgcn_ballot_w64(nd[0] || nd[1]) != 0ull) {
#pragma unroll
            for (int ct = 0; ct < 2; ++ct) {
                const float dl = nd[ct] ? tz[ct] : 0.f;
                const float alpha = nd[ct] ? (un[ct] ? 0.f : __builtin_amdgcn_exp2f(-tz[ct])) : 1.f;
                st.m[ct] = nd[ct] ? ((un[ct] ? 0.f : st.m[ct]) + tz[ct]) : st.m[ct];
                st.l[ct] *= alpha;
#pragma unroll
                for (int dt = 0; dt < 4; ++dt) st.o[ct][dt] = st.o[ct][dt] * alpha;
#pragma unroll
                for (int sb = 0; sb < 4; ++sb) s[ct][sb] = s[ct][sb] - dl;
            }
        }
#pragma unroll
        for (int ct = 0; ct < 2; ++ct) {
            float ls = 0.f;
#pragma unroll
            for (int sb = 0; sb < 4; ++sb)
#pragma unroll
                for (int j = 0; j < 4; ++j) { const float pe = __builtin_amdgcn_exp2f(s[ct][sb][j]); s[ct][sb][j] = pe; ls += pe; }
            st.l[ct] += ls;
        }
    } else {
    float tmaxv[2]; bool need[2];
#pragma unroll
    for (int ct = 0; ct < 2; ++ct) {
        float tmax = -1e30f;
#pragma unroll
        for (int sb = 0; sb < 4; ++sb)
#pragma unroll
            for (int j = 0; j < 4; ++j) {
                if (!FAST) s[ct][sb][j] = ((vbits >> (sb * 4 + j)) & 1u) ? s[ct][sb][j] : -1e30f;
                tmax = fmaxf(tmax, s[ct][sb][j]);
            }
        if (FAST && MODE == M_SLC) tmax = mybit ? tmax : -1e30f;
        tmax = fmaxf(tmax, __shfl_xor(tmax, 16)); tmax = fmaxf(tmax, __shfl_xor(tmax, 32));
        tmaxv[ct] = tmax; need[ct] = tmax > st.m[ct] + ATT_THR;
    }
    if (__builtin_amdgcn_ballot_w64(need[0] || need[1]) != 0ull) {
#pragma unroll
        for (int ct = 0; ct < 2; ++ct) {
            const float alpha = need[ct] ? __builtin_amdgcn_exp2f(st.m[ct] - tmaxv[ct]) : 1.f;
            st.m[ct] = need[ct] ? tmaxv[ct] : st.m[ct];
            st.l[ct] *= alpha;
            if (MODE != M_CMP1) {
#pragma unroll
                for (int dt = 0; dt < 4; ++dt) st.o[ct][dt] = st.o[ct][dt] * alpha;
            }
        }
    }
#pragma unroll
    for (int ct = 0; ct < 2; ++ct) {
        const float mu = (FAST && MODE == M_SLC && !mybit) ? 1e30f : st.m[ct];
        float ls = 0.f;
#pragma unroll
        for (int sb = 0; sb < 4; ++sb)
#pragma unroll
            for (int j = 0; j < 4; ++j) {
                float pe = __builtin_amdgcn_exp2f(s[ct][sb][j] - mu);
                if (!FAST) pe = ((vbits >> (sb * 4 + j)) & 1u) ? pe : 0.f;
                s[ct][sb][j] = pe; ls += pe;
            }
        st.l[ct] += ls;
    }
    }
    if (MODE != M_CMP1) {
#pragma unroll
        for (int kg = 0; kg < 2; ++kg)
#pragma unroll
            for (int ct = 0; ct < 2; ++ct) { u32x4v w; w.x = cvt_pk_bf16(s[ct][2 * kg][0], s[ct][2 * kg][1]); w.y = cvt_pk_bf16(s[ct][2 * kg][2], s[ct][2 * kg][3]);
                w.z = cvt_pk_bf16(s[ct][2 * kg + 1][0], s[ct][2 * kg + 1][1]); w.w = cvt_pk_bf16(s[ct][2 * kg + 1][2], s[ct][2 * kg + 1][3]); pfo[kg][ct] = __builtin_bit_cast(bf16x8, w); }
        if (MODE == M_SLC || MODE == M_WIN) attn_pvr(st, vfe, pfo); else if (!DEFER) attn_pv(st, Vt, pfo, fr, fq);
    }
}

template <int MODE>
__device__ __forceinline__ void attn_branch(AttnState& st, const bf16_t* __restrict__ Kg, const bf16_t* __restrict__ Vg, u64 tiles, LAS bf16_t* KsB, LAS bf16_t* VtB,
                                            int tq, u64 mymask, int cur, int fr, int fq, float (&imp)[16]) {
    const int otid = opaque_tid();
    const int tid = otid;
    const int kkey = tid >> 3, kch = tid & 7;
    const bool late = false;
    float prev_t3 = 0.f;
    if (tiles == 0ull) return;
    int jb = __builtin_ctzll(tiles); tiles &= tiles - 1ull;
    u32x4v kr = *(const u32x4v*)(Kg + (size_t)(jb * 64 + kkey) * 64 + kch * 8), vr = (u32x4v){0u, 0u, 0u, 0u};
    if (MODE != M_CMP1) vr = *(const u32x4v*)(Vg + (size_t)(jb * 64 + kkey) * 64 + kch * 8);
    int pb = 0, vb = 0, vprev = 0; bool have = false;
    bf16x8 pf[2][2];
    for (;;) {
        LAS bf16_t* Ks = KsB + pb * (64 * KSTR); LAS bf16_t* Vt = VtB + vb * (64 * KSTR);
        *(LAS u32x4v*)(Ks + kkey * KSTR + kch * 8) = kr;
        if (MODE != M_CMP1) *(LAS u32x4v*)(Vt + kkey * KSTR + kch * 8) = vr;
        int jn = -1;
        if (tiles != 0ull) { jn = __builtin_ctzll(tiles); tiles &= tiles - 1ull;
            kr = *(const u32x4v*)(Kg + (size_t)(jn * 64 + kkey) * 64 + kch * 8);
            if (MODE != M_CMP1) vr = *(const u32x4v*)(Vg + (size_t)(jn * 64 + kkey) * 64 + kch * 8); }
        __syncthreads();
        if (late && have) { attn_pv(st, VtB + vprev * (64 * KSTR), pf, fr, fq); have = false; }
        const bool mybit = (mymask >> jb) & 1ull;
        bool active = true;
        if (MODE == M_SLC) active = __builtin_amdgcn_ballot_w64(mybit) != 0ull;
        if (active) {
            if (MODE == M_SLC || MODE == M_WIN) {
                const bool fast = (MODE == M_SLC) ? (jb != cur) : (jb != cur && jb != cur - 8);
                if (fast) attn_tile<MODE, true, true>(st, Ks, Vt, jb, tq, mybit, fr, fq, imp, prev_t3, pf); else attn_tile<MODE, false, true>(st, Ks, Vt, jb, tq, mybit, fr, fq, imp, prev_t3, pf);
                (void)have; (void)vprev;
            } else attn_tile<MODE, false, false>(st, Ks, Vt, jb, tq, mybit, fr, fq, imp, prev_t3, pf);
        }
        if (jn < 0) break;
        jb = jn; pb ^= 1; vb = vb == 2 ? 0 : vb + 1;
    }
    if (late && have) attn_pv(st, VtB + vprev * (64 * KSTR), pf, fr, fq);
    __syncthreads();
}

__device__ __forceinline__ void attn_phase(const Args& a, LAS unsigned char* lds) {
    const int otid = opaque_tid();
    const bf16_t* Q = (const bf16_t*)(a.ws + WS_R1 + R1_Q);
    const bf16_t* KV = (const bf16_t*)(a.ws + WS_R1 + R1_KV);
    const bf16_t* KC = (const bf16_t*)(a.ws + WS_KC);
    const float* NG = (const float*)(a.ws + WS_NG);
    const float* RT = (const float*)(a.ws + WS_ROPE);
    bf16_t* YS = (bf16_t*)(a.ws + WS_R2);
    LAS bf16_t* Ks = (LAS bf16_t*)lds;
    LAS bf16_t* Vt = (LAS bf16_t*)(lds + 2 * 64 * KSTR * 2);
    LAS u64* um = (LAS u64*)(lds + 5 * 64 * KSTR * 2);
    const int tid = otid, lane = tid & 63, w = tid >> 6, fr = lane & 15, fq = lane >> 4;
    for (int i = blockIdx.x; i < 1024; i += gridDim.x) {
        const int c = i & 255, itn = i >> 8, bg = (c & 7) * 2 + (c >> 7), mm = (c >> 3) & 15;
        const int qb = itn == 0 ? mm : (itn == 1 ? 31 - mm : (itn == 2 ? 32 + mm : 63 - mm));
        const int b = bg >> 1, g = bg & 1, q0 = qb * 64, cur = qb;
        const int tq = q0 + 8 * w + (fr & 7);
        const size_t row = (size_t)b * SQ + tq;
        AttnState st;
        LAS float* oacc = (LAS float*)(lds + 49152) + tid;
        float imp[16];
#pragma unroll
        for (int k = 0; k < 16; ++k) imp[k] = 0.f;
#pragma unroll
        for (int ct = 0; ct < 2; ++ct) { const int h = g * 4 + 2 * ct + (fr >> 3);
#pragma unroll
            for (int kk = 0; kk < 2; ++kk) st.qf[ct][kk] = __builtin_bit_cast(bf16x8, *(const u32x4v*)(Q + row * 512 + h * 64 + kk * 32 + fq * 8)); }
        const bf16_t* kc = KC + (size_t)bg * 256 * 64; const bf16_t* vc = KC + (size_t)(16 + bg) * 256 * 64;
#pragma unroll
        for (int ct = 0; ct < 2; ++ct) { st.m[ct] = -1e30f; st.l[ct] = 0.f;
#pragma unroll
            for (int dt = 0; dt < 4; ++dt) st.o[ct][dt] = (f32x4){0.f, 0.f, 0.f, 0.f}; }
        const int ncmp = (q0 + 32) / 1024 + 1;
        const u64 cmpt = (1ull << (ncmp > 4 ? 4 : ncmp)) - 1ull;
        attn_branch<M_CMP1>(st, kc, vc, cmpt, Ks, Vt, tq, 0ull, cur, fr, fq, imp);
#pragma unroll
        for (int ct = 0; ct < 2; ++ct) { float lt = st.l[ct]; lt += __shfl_xor(lt, 16); lt += __shfl_xor(lt, 32); st.l[ct] = lt; }
        attn_branch<M_CMP2>(st, kc, vc, cmpt, Ks, Vt, tq, 0ull, cur, fr, fq, imp);
        {
#pragma unroll
            for (int ct = 0; ct < 2; ++ct) { const int h = g * 4 + 2 * ct + (fr >> 3); const float gt = sigm(NG[row * 24 + h * 3 + 0]);
#pragma unroll
                for (int dt = 0; dt < 4; ++dt)
#pragma unroll
                    for (int j = 0; j < 4; ++j) oacc[((ct * 4 + dt) * 4 + j) * 512] = st.o[ct][dt][j] * gt; }
        }
        u64 mymask = 0ull;
        if (cur < 16) mymask = (2ull << cur) - 1ull;
        else {
            float sc[16]; int rank[16];
#pragma unroll
            for (int k = 0; k < 16; ++k) { const int jb = 4 * k + fq; const bool forced = (jb == 0) || (jb == cur) || (jb == cur - 1);
                sc[k] = forced ? 1e4f : (jb <= cur ? imp[k] : -1.f); rank[k] = 0; }
#pragma unroll 1
            for (int f2 = 0; f2 < 4; ++f2)
#pragma unroll
                for (int k2 = 0; k2 < 16; ++k2) {
                    const float ov = __shfl(sc[k2], fr + 16 * f2); const int ob = 4 * k2 + f2;
#pragma unroll
                    for (int k = 0; k < 16; ++k) { const int jb = 4 * k + fq; rank[k] += ((ov > sc[k]) || (ov == sc[k] && ob < jb)) ? 1 : 0; }
                }
#pragma unroll
            for (int k = 0; k < 16; ++k) { const int jb = 4 * k + fq; if (rank[k] < 16 && jb <= cur) mymask |= 1ull << jb; }
            mymask |= __shfl_xor(mymask, 16); mymask |= __shfl_xor(mymask, 32);
        }
        u64 un = mymask;
        un |= __shfl_xor(un, 1); un |= __shfl_xor(un, 2); un |= __shfl_xor(un, 4);
        __syncthreads();
        { const int t2 = opaque_tid(); if ((t2 & 63) == 0) um[t2 >> 6] = un; }
        __syncthreads();
        u64 bun = 0ull;
#pragma unroll
        for (int k = 0; k < 8; ++k) bun |= um[k];
        {
            float cs[8], sn[8];
#pragma unroll
            for (int e = 0; e < 8; ++e) { cs[e] = RT[(tq * 8 + e) * 2]; sn[e] = RT[(tq * 8 + e) * 2 + 1]; }
#pragma unroll
            for (int ct = 0; ct < 2; ++ct)
#pragma unroll
                for (int kk = 0; kk < 2; ++kk) {
                    const int hq = g * 4 + 2 * ct + (fr >> 3);
                    const u32x4v qv = *(const u32x4v*)(Q + row * 512 + hq * 64 + kk * 32 + fq * 8);
                    const unsigned qw[4] = {qv.x, qv.y, qv.z, qv.w};
                    float r[8];
#pragma unroll
                    for (int e = 0; e < 8; ++e) {
                        const float x = (e & 1) ? __uint_as_float(qw[e >> 1] & 0xffff0000u) : __uint_as_float(qw[e >> 1] << 16);
                        if (kk == 0) { const float ot = __shfl_xor(x, 16); r[e] = (fq == 0 ? x * cs[e] - ot * sn[e] : (fq == 1 ? x * cs[e] + ot * sn[e] : x)) * ATT_QS; }
                        else r[e] = x * ATT_QS;
                    }
                    u32x4v o; o.x = cvt_pk_bf16(r[0], r[1]); o.y = cvt_pk_bf16(r[2], r[3]); o.z = cvt_pk_bf16(r[4], r[5]); o.w = cvt_pk_bf16(r[6], r[7]);
                    st.qf[ct][kk] = __builtin_bit_cast(bf16x8, o);
                }
        }
#pragma unroll
        for (int ct = 0; ct < 2; ++ct) { st.m[ct] = -1e30f; st.l[ct] = 0.f;
#pragma unroll
            for (int dt = 0; dt < 4; ++dt) st.o[ct][dt] = (f32x4){0.f, 0.f, 0.f, 0.f}; }
        attn_branch<M_SLC>(st, KV + 2 * KVSZ + (size_t)bg * 4096 * 64, KV + 3 * KVSZ + (size_t)bg * 4096 * 64, bun, Ks, Vt, tq, mymask, cur, fr, fq, imp);
#pragma unroll
        for (int ct = 0; ct < 2; ++ct) { const int h = g * 4 + 2 * ct + (fr >> 3); float lt = st.l[ct]; lt += __shfl_xor(lt, 16); lt += __shfl_xor(lt, 32);
            const float gt = sigm(NG[row * 24 + h * 3 + 1]) * (lt > 0.f ? 1.f / lt : 0.f);
#pragma unroll
            for (int dt = 0; dt < 4; ++dt)
#pragma unroll
                for (int j = 0; j < 4; ++j) oacc[((ct * 4 + dt) * 4 + j) * 512] += st.o[ct][dt][j] * gt; }
#pragma unroll
        for (int ct = 0; ct < 2; ++ct) { st.m[ct] = -1e30f; st.l[ct] = 0.f;
#pragma unroll
            for (int dt = 0; dt < 4; ++dt) st.o[ct][dt] = (f32x4){0.f, 0.f, 0.f, 0.f}; }
        {
            const int lo = cur - 8 < 0 ? 0 : cur - 8;
            const u64 hi_m = cur == 63 ? ~0ull : ((1ull << (cur + 1)) - 1ull);
            const u64 wt = hi_m & ~((1ull << lo) - 1ull);
            attn_branch<M_WIN>(st, KV + 4 * KVSZ + (size_t)bg * 4096 * 64, KV + 5 * KVSZ + (size_t)bg * 4096 * 64, wt, Ks, Vt, tq, 0ull, cur, fr, fq, imp);
        }
#pragma unroll
        for (int ct = 0; ct < 2; ++ct) { const int h = g * 4 + 2 * ct + (fr >> 3); float lt = st.l[ct]; lt += __shfl_xor(lt, 16); lt += __shfl_xor(lt, 32);
            const float gt = sigm(NG[row * 24 + h * 3 + 2]) * (lt > 0.f ? 1.f / lt : 0.f);
#pragma unroll
            for (int dt = 0; dt < 4; ++dt) { f32x4 v;
#pragma unroll
                for (int j = 0; j < 4; ++j) v[j] = oacc[((ct * 4 + dt) * 4 + j) * 512] + st.o[ct][dt][j] * gt;
                *(u32x2*)(YS + row * 1536 + 512 + h * 64 + dt * 16 + fq * 4) = pack4(v); } }
    }
    __syncthreads();
}
#define XB_TMO      128
#define XB_XCNT(j)  (256  + 64 * (j))
#define XB_XSUB(j)  (1280 + 64 * (j))
#define XB_XGEN(j)  (2304 + 64 * (j))
#define XB_TOP      3328
#define XB_TOPGEN   3392
#define XCD_BAR_WORDS 3456
#define XB_SPIN_CAP (1u << 18)

__device__ __forceinline__ unsigned xb_ld(unsigned* p)              { return __hip_atomic_load(p, __ATOMIC_RELAXED, __HIP_MEMORY_SCOPE_AGENT); }
__device__ __forceinline__ unsigned xb_add(unsigned* p, unsigned v) { return __hip_atomic_fetch_add(p, v, __ATOMIC_RELAXED, __HIP_MEMORY_SCOPE_AGENT); }
__device__ __forceinline__ unsigned xb_xcc_id() { return (unsigned)__builtin_amdgcn_s_getreg((3 << 11) | 20) & 0xFu; }
#define XB_SPIN(cond, bar) do { unsigned _sp = 0; while (cond) { __builtin_amdgcn_s_sleep(1); \
    if ((++_sp & 255u) == 0u) { if (xb_ld(&(bar)[XB_TMO])) break; if (_sp > XB_SPIN_CAP) { atomicAdd(&(bar)[XB_TMO], 1u); break; } } } } while (0)

struct XcdBarrier {
    unsigned* bar; unsigned x;
    volatile LAS unsigned* st;
};

__device__ __forceinline__ XcdBarrier xcd_barrier_post(unsigned* bar, volatile LAS unsigned* st) {
    XcdBarrier b; b.bar = bar; b.x = xb_xcc_id(); b.st = st;
    if (threadIdx.x == 0) (void)xb_add(&bar[XB_XCNT(b.x)], 1u);
    return b;
}
__device__ __forceinline__ void xcd_barrier_complete(unsigned* bar, unsigned x, unsigned& nloc, unsigned& nx) {
    const unsigned G = gridDim.x * gridDim.y * gridDim.z;
    unsigned sum, cnt, mine, sp = 0u;
    for (;;) {
        sum = 0u; cnt = 0u; mine = 0u;
#pragma unroll
        for (unsigned j = 0; j < 16; ++j) { const unsigned c = xb_ld(&bar[XB_XCNT(j)]); sum += c; cnt += (c > 0u) ? 1u : 0u; mine = (j == x) ? c : mine; }
        if (sum == G) break;
        __builtin_amdgcn_s_sleep(1);
        if ((++sp & 255u) == 0u) { if (xb_ld(&bar[XB_TMO])) break; if (sp > XB_SPIN_CAP) { atomicAdd(&bar[XB_TMO], 1u); break; } }
    }
    nloc = mine > 0u ? mine : 1u; nx = cnt > 0u ? cnt : 1u;
}

__device__ __forceinline__ void xcd_barrier(const XcdBarrier& b) {
    asm volatile("s_waitcnt vmcnt(0)" ::: "memory");
    __syncthreads();
    if (threadIdx.x == 0) {
        unsigned* bar = b.bar;
        __builtin_amdgcn_s_waitcnt(0);
        unsigned nloc = b.st[0], nx = b.st[1];
        if (nloc == 0u) { xcd_barrier_complete(bar, b.x, nloc, nx); b.st[0] = nloc; b.st[1] = nx; }
        const unsigned old = xb_add(&bar[XB_XSUB(b.x)], 1u);
        const unsigned gen = old / nloc;
        if (old + 1u == (gen + 1u) * nloc) {
            __builtin_amdgcn_fence(__ATOMIC_RELEASE, "agent");
            asm volatile("s_waitcnt vmcnt(0)" ::: "memory");
            const unsigned og = xb_add(&bar[XB_TOP], 1u);
            const unsigned tg = og / nx;
            if (og + 1u == (tg + 1u) * nx) xb_add(&bar[XB_TOPGEN], 1u);
            else XB_SPIN(xb_ld(&bar[XB_TOPGEN]) == tg, bar);
            __builtin_amdgcn_fence(__ATOMIC_ACQUIRE, "agent");
            xb_add(&bar[XB_XGEN(b.x)], 1u);
            asm volatile("s_waitcnt vmcnt(0)" ::: "memory");
        } else {
            XB_SPIN(xb_ld(&bar[XB_XGEN(b.x)]) == gen, bar);
            __builtin_amdgcn_fence(__ATOMIC_ACQUIRE, "agent");
            asm volatile("s_waitcnt vmcnt(0)" ::: "memory");
        }
    }
    __syncthreads();
}

#ifndef REP_SYNC
#define REP_SYNC 1
#endif
#ifndef USE_CG
#define USE_CG 0
#endif
#define GSYNC() do { for (int rs_ = 0; rs_ < REP_SYNC; ++rs_) { if (USE_CG) grid.sync(); else xcd_barrier(xbar); } } while (0)
#ifndef PROBE_NORM
#define PROBE_NORM 0
#endif
#ifndef PROBE_CB
#define PROBE_CB 0
#endif
#ifndef REP_ATTN
#define REP_ATTN 1
#endif
#ifndef REP_FFN
#define REP_FFN 1
#endif
#ifndef REP_MIXG
#define REP_MIXG 1
#endif
#ifndef REP_SMALL
#define REP_SMALL 1
#endif
#ifndef REP_PRO
#define REP_PRO 1
#endif
__global__ void __launch_bounds__(NTHR) mega_fwd(Args a) {
    extern __shared__ __attribute__((aligned(16))) unsigned char lds_raw[];
    LAS unsigned char* lds = (LAS unsigned char*)lds_raw;
    cg::grid_group grid = cg::this_grid();
    unsigned char* ws = a.ws;
    bf16_t* H = (bf16_t*)(ws + WS_H);
    bf16_t* ACT = (bf16_t*)(ws + WS_R1 + R1_ACT);
    bf16_t* Y1 = (bf16_t*)(ws + WS_R1 + R1_Y1);
    bf16_t* Y2 = (bf16_t*)(ws + WS_R2);
    bf16_t* GATES = (bf16_t*)(ws + WS_R1 + R1_GATES);
    bf16_t* YS = (bf16_t*)(ws + WS_R2);
    const float* MOD = (const float*)(ws + WS_MOD);
    const float* NG_ = a.in[I_NORMG];

    volatile LAS unsigned* xst = (volatile LAS unsigned*)(lds + LDS_BYTES - 16);
    if (threadIdx.x == 0) { xst[0] = 0u; xst[1] = 0u; xst[2] = 0u; xst[3] = 0u; }
    __syncthreads();
    XcdBarrier xbar = xcd_barrier_post((unsigned*)(ws + WS_BAR), xst);
    for (int rep = 0; rep < REP_PRO; ++rep) {
    convert_weights(a, 0, lds);
    __syncthreads();
    mod_rope_phase(a, lds);
    if (a.ws == nullptr) grid.sync();
    GSYNC();
    }
    norm_phase(a.in[I_X], false, nullptr, nullptr, nullptr, 0.f, NG_ + 0 * DM, MOD + 0 * DM, MOD + 1 * DM, nullptr, false, H);
    GSYNC();
#pragma unroll 1
    for (int hl = 0; hl < 4; ++hl) {
        const int l = hl >> 1, f = hl & 1;
        const float* ng = NG_ + (size_t)l * 6 * DM;
        const float* mod = MOD + (size_t)l * 8 * 9216;
        for (int rep = 0; rep < REP_FFN; ++rep) {
        { EpiSwiglu E; E.O = ACT; run_gemm(lds, H, 1024, (const bf16_t*)(ws + WS_W13 + f * SZ_W13), 1024, NTOK, 5632, 1024, 1 << 20, 0, E); }
        GSYNC();
        { EpiPlain E; E.O = Y1; E.ldc = DM; run_gemm(lds, ACT, DFF, (const bf16_t*)(ws + WS_W2 + f * SZ_W2), DFF, NTOK, 1024, DFF, 1 << 20, 0, E); }
        GSYNC();
        }
        if (f == 0) {
            norm_phase(l == 0 ? (const void*)a.in[I_X] : (const void*)a.out, l != 0, Y1, ng + 1 * DM, mod + 2 * DM, 0.5f, ng + 2 * DM, mod + 3 * DM, mod + 4 * DM, a.out, true, H);
            GSYNC();
            for (int rep = 0; rep < REP_MIXG; ++rep) {
            { EpiWin E; E.AIN = (bf16_t*)(ws + WS_R1 + R1_AIN); E.Q = (bf16_t*)(ws + WS_R1 + R1_Q); E.KV = (bf16_t*)(ws + WS_R1 + R1_KV); E.C = (bf16_t*)(ws + WS_R1 + R1_C); E.NG = (float*)(ws + WS_NG);
              run_gemm(lds, H, 1024, (const bf16_t*)(ws + WS_WIN), 1024, NTOK, 4096, 1024, 1 << 20, 0, E); }
            GSYNC();
            }
            for (int rep = 0; rep < REP_SMALL; ++rep) gmlp_phase(a, l, lds);
            if (PROBE_CB) conv_rope_phase(a, l, false);
            conv_rope_phase(a, l, true);
            for (int rep = 0; rep < REP_SMALL; ++rep)
            for (int kk2 = 0; kk2 < 4; ++kk2) {
                const int kv = kk2 >> 1, kh = kk2 & 1;
                EpiUL E; E.O = (float*)(ws + WS_UL) + (size_t)(kh * 2 + kv) * 4096 * 256;
                run_gemm(lds, (const bf16_t*)(ws + WS_R1 + R1_KV) + (size_t)kv * KVSZ + kh * 512, 1024, (const bf16_t*)(ws + WS_WC1) + (size_t)kv * 256 * 1024 + kh * 512, 1024, 4096, 256, 512, 1 << 20, 0, E, 64 * kk2);
            }
            GSYNC();
            for (int rep = 0; rep < REP_SMALL; ++rep) cmp2_phase(a, l, lds);
            GSYNC();
            for (int rep = 0; rep < REP_ATTN; ++rep) {
            attn_phase(a, lds);
            GSYNC();
            }
            for (int rep = 0; rep < REP_MIXG; ++rep) {
            { EpiSigmoid E; E.O = GATES; E.ldc = 3072; run_gemm(lds, H, 1024, (const bf16_t*)(ws + WS_WG), 1024, NTOK, 3072, 1024, 1 << 20, 0, E); }
            GSYNC();
            }
            { EpiBranchAcc E; E.G = GATES; E.Mg = H;
              pg8::Gemm g; g.A = YS; g.Bt = (const bf16_t*)(ws + WS_WB); g.M = NTOK; g.N = 3072; g.K = 512; g.lda = 1536; g.ldb = 512; g.adiv = 4; g.aoff = 512;
              BranchOrder S; S.init(NTOK, (int)gridDim.x, (int)blockIdx.x);
              pg8::gemm_phase<EpiBranchAcc, BranchOrder, true, true>((PG8_LAS unsigned char*)lds, g, S, E);
              __syncthreads(); }
            GSYNC();
            for (int rep = 0; rep < REP_MIXG; ++rep) {
            { EpiPlain E; E.O = Y2; E.ldc = DM; run_gemm(lds, H, 1024, (const bf16_t*)(ws + WS_WO3), 1024, NTOK, 1024, 1024, 1 << 20, 0, E); }
            GSYNC();
            }
            norm_phase(a.out, true, Y2, ng + 3 * DM, mod + 5 * DM, 1.0f, ng + 4 * DM, mod + 6 * DM, mod + 7 * DM, l == 0 ? (void*)a.out : (void*)Y2, true, H);
            GSYNC();
        } else {
            if (l == 0) {
                norm_phase(a.out, true, Y1, ng + 5 * DM, mod + 8 * DM, 0.5f, NG_ + (size_t)6 * DM, MOD + (size_t)8 * 9216 + 0 * DM, MOD + (size_t)8 * 9216 + 1 * DM, a.out, true, H);
                convert_weights(a, 1, lds);
            } else {
                norm_phase(Y2, true, Y1, ng + 5 * DM, mod + 8 * DM, 0.5f, nullptr, nullptr, nullptr, a.out, false, nullptr);
            }
            GSYNC();
        }
    }
}

extern "C" void kernel_launch(void* const* d_in, const int* in_sizes, int n_in, void* d_out, int out_size, void* d_ws, size_t ws_size, hipStream_t stream) {
    static int grid = 0;
    if (grid == 0) {
        if (n_in != N_IN || ws_size < WS_END) { fprintf(stderr, "kernel_launch: bad n_in %d or ws_size %zu (need %zu)\n", n_in, ws_size, (size_t)WS_END); grid = -1; return; }
        int dev = 0, cus = 0, per_cu = 0;
        hipGetDevice(&dev);
        hipDeviceGetAttribute(&cus, hipDeviceAttributeMultiprocessorCount, dev);
        if (hipFuncSetAttribute((const void*)mega_fwd, hipFuncAttributeMaxDynamicSharedMemorySize, LDS_BYTES) != hipSuccess) { fprintf(stderr, "kernel_launch: hipFuncSetAttribute failed\n"); grid = -1; return; }
        hipOccupancyMaxActiveBlocksPerMultiprocessor(&per_cu, (const void*)mega_fwd, NTHR, LDS_BYTES);
        (void)hipGetLastError();
        if (per_cu < 1) per_cu = 1;
        grid = cus * 1;
        fprintf(stderr, "kernel_launch: cus %d per_cu %d grid %d\n", cus, per_cu, grid);
    }
    if (grid < 0) return;
    if (hipMemsetAsync((unsigned char*)d_ws + WS_BAR, 0, XCD_BAR_WORDS * 4, stream) != hipSuccess) { fprintf(stderr, "kernel_launch: memset failed\n"); return; }
    Args a{};
    for (int i = 0; i < N_IN; ++i) a.in[i] = (const float*)d_in[i];
    a.out = (float*)d_out; a.ws = (unsigned char*)d_ws;
    void* args[] = {&a};
    hipError_t e = hipLaunchCooperativeKernel((const void*)mega_fwd, dim3(grid), dim3(NTHR), args, LDS_BYTES, stream);
    if (e != hipSuccess) fprintf(stderr, "cooperative launch failed: %s (grid %d)\n", hipGetErrorString(e), grid);
}
```

```cpp
#include <hip/hip_runtime.h>
#include <hip/hip_cooperative_groups.h>
#include <cstdio>
#include <cstdint>
namespace cg = cooperative_groups;
__device__ __forceinline__ int opaque_tid() { int t = (int)threadIdx.x; asm volatile("" : "+v"(t)); return t; }
namespace pg8 {
#define PG8_LAS __attribute__((address_space(3)))
typedef unsigned short bf16_t;
typedef short bf16x8 __attribute__((ext_vector_type(8)));
typedef float f32x4 __attribute__((ext_vector_type(4)));
typedef unsigned u32x4 __attribute__((ext_vector_type(4)));
constexpr int BM = 256, BK = 64, HALF = 128, HTB = HALF * BK * 2  , STAGE_BYTES = 8 * HTB, NXCD = 8, WGM = 2;

__host__ __device__ __forceinline__ int lds_byte(int r, int c) { const int st = (r >> 4) * 2 + (c >> 5), rr = r & 15, cc = c & 31, ob = rr * 64 + cc * 2; return st * 1024 + (ob ^ (((ob >> 9) & 1) << 5)); }
__host__ __device__ __forceinline__ void stage_rc(int b, int& R, int& C) { const int st = b / 1024, sb = b % 1024, swz = sb ^ (((sb >> 9) & 1) << 5); R = (st >> 1) * 16 + swz / 64; C = (st & 1) * 32 + (swz % 64) / 2; }
__host__ __device__ __forceinline__ int perm32(int rho) { const int n = rho >> 4, i = rho & 15; return 8 * (i >> 2) + 4 * n + (i & 3); }

struct Unit { int pm, pn; };
struct Gemm { const bf16_t* A; const bf16_t* Bt; int M, N, K, lda, ldb, adiv, aoff; };

struct StaticOrder {
    int nM, nN, nwg, G, c;
    __host__ __device__ void init(int M, int N, int G_, int c_) { nM = M / BM; nN = N / BM; nwg = nM * nN; G = G_; c = c_; }
    __host__ __device__ bool next(int i, Unit& u) const {
        const long L = (long)i * G + c; if (L >= nwg) return false;
        int wgid = (int)L; { const int q = nwg / NXCD, r = nwg % NXCD, xcd = wgid % NXCD, off = wgid / NXCD; wgid = (xcd < r ? xcd * (q + 1) : r * (q + 1) + (xcd - r) * q) + off; }
        const int nig = WGM * nN, gid = wgid / nig, fm = gid * WGM, gsz = (nM - fm) < WGM ? (nM - fm) : WGM;
        u.pm = fm + ((wgid % nig) % gsz); u.pn = (wgid % nig) / gsz; return true;
    }
    __device__ __forceinline__ void a_ready(const Unit&) const {}
    __device__ __forceinline__ void done(const Unit&) const {}
};
typedef float f32x2c __attribute__((ext_vector_type(2)));
typedef __bf16 bf16x2c __attribute__((ext_vector_type(2)));
__device__ __forceinline__ unsigned cvt_pk_bf16(float lo, float hi) { const f32x2c v = {lo, hi}; const bf16x2c r = __builtin_convertvector(v, bf16x2c); return __builtin_bit_cast(unsigned, r); }
template <class Epi, class Sched, bool ALIGN_EPI = false, bool SP2 = false>
__device__ __forceinline__ void gemm_phase(PG8_LAS unsigned char* lds, const Gemm g, const Sched& S, const Epi& E) {
    const int tid = opaque_tid(), wid = __builtin_amdgcn_readfirstlane(tid >> 6), lane = tid & 63, wr = wid >> 2, wc = wid & 3, fr = lane & 15, fq = lane >> 4;
    const int K = g.K, nt = K / BK;
    unsigned voffA[2], voffB[2];
#pragma unroll
    for (int i = 0; i < 2; ++i) { int R, C; stage_rc(tid * 16 + i * 8192, R, C); const int Rb = Epi::PERM ? ((R & ~31) + perm32(R & 31)) : R;
        voffA[i] = (unsigned)(R * g.lda + C) * 2u; voffB[i] = (unsigned)(Rb * g.ldb + C) * 2u; }
    const size_t kstep = (size_t)(BK * 2);
    const size_t hstepA = (size_t)HALF * g.lda * 2, hstepB = (size_t)HALF * g.ldb * 2;
    const size_t tstepA = 2 * hstepA, tstepB = 2 * hstepB;
    const unsigned ldsw = (unsigned)wid * 1024u;
    const int aoff = lds_byte(wr * 64 + fr, fq * 8), boff = lds_byte(wc * 32 + fr, fq * 8);
#define PG8_SA(b, h) (((b) * 2 + (h)) * HTB)
#define PG8_SB(b, h) ((4 + (b) * 2 + (h)) * HTB)
#define PG8_STAGE(bufoff, gbase, voff) do { _Pragma("unroll") for (int _i = 0; _i < 2; ++_i) \
        __builtin_amdgcn_global_load_lds((const unsigned*)((const char*)(gbase) + (voff)[_i]), (PG8_LAS unsigned*)(lds + (bufoff) + ldsw + _i * 8192), 16, 0, 0); } while (0)
#define PG8_LDA(dst, b, h) do { _Pragma("unroll") for (int m = 0; m < 4; ++m) _Pragma("unroll") for (int k = 0; k < 2; ++k) dst[m][k] = *(const PG8_LAS bf16x8*)(lds + PG8_SA(b, h) + aoff + m * 2048 + k * 1024); } while (0)
#define PG8_LDB(dst, b, h) do { _Pragma("unroll") for (int n = 0; n < 2; ++n) _Pragma("unroll") for (int k = 0; k < 2; ++k) dst[n][k] = *(const PG8_LAS bf16x8*)(lds + PG8_SB(b, h) + boff + n * 2048 + k * 1024); } while (0)
#define PG8_MMA(ai, bj, At, Bt) do { __builtin_amdgcn_s_setprio(1); _Pragma("unroll") for (int m = 0; m < 4; ++m) _Pragma("unroll") for (int n = 0; n < 2; ++n) _Pragma("unroll") for (int k = 0; k < 2; ++k) \
        acc[ai][bj][m][n] = __builtin_amdgcn_mfma_f32_16x16x32_bf16(Bt[n][k], At[m][k], acc[ai][bj][m][n], 0, 0, 0); __builtin_amdgcn_s_setprio(0); } while (0)
#define PG8_WAIT_V(n) asm volatile("s_waitcnt vmcnt(" #n ")" ::: "memory")
#define PG8_WAIT_L(n) asm volatile("s_waitcnt lgkmcnt(" #n ")" ::: "memory")
#define PG8_BAR __builtin_amdgcn_s_barrier()
#define PG8_SCHED __builtin_amdgcn_sched_barrier(0)
    Unit cur, nxt; int ui = 0;
    if (!S.next(0, cur)) return;
    f32x4 acc[2][2][4][2];
#pragma unroll
    for (int a = 0; a < 2; ++a)
#pragma unroll
        for (int b = 0; b < 2; ++b)
#pragma unroll
            for (int m = 0; m < 4; ++m)
#pragma unroll
                for (int n = 0; n < 2; ++n) acc[a][b][m][n] = (f32x4){0.f, 0.f, 0.f, 0.f};
    bf16x8 At[4][2], B0[2][2], B1[2][2];
    const char* cA = (const char*)g.A + (size_t)cur.pm * tstepA + (size_t)(cur.pn / g.adiv) * g.aoff * 2; const char* cB = (const char*)g.Bt + (size_t)cur.pn * tstepB;
    S.a_ready(cur);
    if constexpr (SP2) {
        PG8_STAGE(PG8_SB(0, 0), cB, voffB); PG8_STAGE(PG8_SB(0, 1), cB + hstepB, voffB); PG8_STAGE(PG8_SA(0, 0), cA, voffA); PG8_STAGE(PG8_SA(0, 1), cA + hstepA, voffA);
        if (wr == 1) PG8_BAR;
        PG8_WAIT_V(2); PG8_BAR;
        PG8_STAGE(PG8_SB(1, 0), cB + kstep, voffB); PG8_STAGE(PG8_SA(1, 0), cA + kstep, voffA); PG8_STAGE(PG8_SB(1, 1), cB + hstepB + kstep, voffB);
        PG8_WAIT_V(6); PG8_BAR;
    } else {
        PG8_STAGE(PG8_SB(0, 0), cB, voffB); PG8_STAGE(PG8_SA(0, 0), cA, voffA); PG8_STAGE(PG8_SB(0, 1), cB + hstepB, voffB); PG8_STAGE(PG8_SA(0, 1), cA + hstepA, voffA);
        if (wr == 1) PG8_BAR;
        PG8_WAIT_V(4); PG8_BAR;
        PG8_STAGE(PG8_SB(1, 0), cB + kstep, voffB); PG8_STAGE(PG8_SA(1, 0), cA + kstep, voffA); PG8_STAGE(PG8_SB(1, 1), cB + hstepB + kstep, voffB);
        PG8_WAIT_V(6); PG8_BAR;
    }
    for (;;) {
        const bool has_next = S.next(ui + 1, nxt);
        const char* nA = has_next ? (const char*)g.A + (size_t)nxt.pm * tstepA + (size_t)(nxt.pn / g.adiv) * g.aoff * 2 : cA; const char* nB = has_next ? (const char*)g.Bt + (size_t)nxt.pn * tstepB : cB;
        for (int t = 0; t < nt; t += 2) {
            const bool last = (t == nt - 2);
            const char* a1 = cA + (size_t)(t + 1) * kstep;
            const char* a2 = last ? nA : cA + (size_t)(t + 2) * kstep; const char* b2 = last ? nB : cB + (size_t)(t + 2) * kstep;
            const char* a3 = a2 + kstep; const char* b3 = b2 + kstep;
            if (last && has_next) S.a_ready(nxt);
            if constexpr (SP2) {
            PG8_LDB(B0, 0, 0); PG8_LDB(B1, 0, 1); PG8_SCHED; PG8_LDA(At, 0, 0); PG8_STAGE(PG8_SA(1, 1), a1 + hstepA, voffA);
            PG8_WAIT_V(8); PG8_WAIT_L(0); PG8_BAR; PG8_MMA(0, 0, At, B0); PG8_MMA(0, 1, At, B1); PG8_BAR; PG8_SCHED;
            PG8_LDA(At, 0, 1); PG8_STAGE(PG8_SB(0, 0), b2, voffB); PG8_STAGE(PG8_SB(0, 1), b2 + hstepB, voffB); PG8_STAGE(PG8_SA(0, 0), a2, voffA);
            PG8_WAIT_V(8); PG8_WAIT_L(0); PG8_BAR; PG8_MMA(1, 0, At, B0); PG8_MMA(1, 1, At, B1); PG8_BAR; PG8_SCHED;
            PG8_LDB(B0, 1, 0); PG8_LDB(B1, 1, 1); PG8_SCHED; PG8_LDA(At, 1, 0); PG8_STAGE(PG8_SA(0, 1), a2 + hstepA, voffA);
            PG8_WAIT_V(8); PG8_WAIT_L(0); PG8_BAR; PG8_MMA(0, 0, At, B0); PG8_MMA(0, 1, At, B1); PG8_BAR; PG8_SCHED;
            PG8_LDA(At, 1, 1); PG8_STAGE(PG8_SB(1, 0), b3, voffB); PG8_STAGE(PG8_SB(1, 1), b3 + hstepB, voffB); PG8_STAGE(PG8_SA(1, 0), a3, voffA);
            PG8_WAIT_V(8); PG8_WAIT_L(0); PG8_BAR; PG8_MMA(1, 0, At, B0); PG8_MMA(1, 1, At, B1); PG8_BAR; PG8_SCHED;
            } else {
            PG8_LDB(B0, 0, 0); PG8_SCHED; PG8_LDA(At, 0, 0); PG8_STAGE(PG8_SA(1, 1), a1 + hstepA, voffA);
            PG8_WAIT_L(8); PG8_BAR; PG8_WAIT_L(0); PG8_MMA(0, 0, At, B0); PG8_BAR; PG8_SCHED;
            PG8_LDB(B1, 0, 1); PG8_STAGE(PG8_SB(0, 0), b2, voffB);
            PG8_BAR; PG8_WAIT_L(0); PG8_MMA(0, 1, At, B1); PG8_BAR;
            PG8_LDA(At, 0, 1); PG8_STAGE(PG8_SA(0, 0), a2, voffA);
            PG8_BAR; PG8_WAIT_L(0); PG8_MMA(1, 0, At, B0); PG8_BAR; PG8_SCHED;
            PG8_STAGE(PG8_SB(0, 1), b2 + hstepB, voffB);
            PG8_WAIT_V(6); PG8_BAR; PG8_MMA(1, 1, At, B1); PG8_BAR;
            PG8_LDB(B0, 1, 0); PG8_SCHED; PG8_LDA(At, 1, 0); PG8_STAGE(PG8_SA(0, 1), a2 + hstepA, voffA);
            PG8_WAIT_L(8); PG8_BAR; PG8_WAIT_L(0); PG8_MMA(0, 0, At, B0); PG8_BAR; PG8_SCHED;
            PG8_LDB(B1, 1, 1); PG8_STAGE(PG8_SB(1, 0), b3, voffB);
            PG8_BAR; PG8_WAIT_L(0); PG8_MMA(0, 1, At, B1); PG8_BAR;
            PG8_LDA(At, 1, 1); PG8_STAGE(PG8_SA(1, 0), a3, voffA);
            PG8_BAR; PG8_WAIT_L(0); PG8_MMA(1, 0, At, B0); PG8_BAR; PG8_SCHED;
            PG8_STAGE(PG8_SB(1, 1), b3 + hstepB, voffB);
            PG8_WAIT_V(6); PG8_BAR; PG8_MMA(1, 1, At, B1); PG8_BAR;
            }
        }
        if constexpr (ALIGN_EPI) { if (wr == 0) PG8_BAR; }
        if constexpr (!Epi::AFTER_DRAIN) { E(acc, cur, wr, wc, fr, fq); S.done(cur); }
        if (!has_next) break;
#pragma unroll
        for (int a = 0; a < 2; ++a)
#pragma unroll
            for (int b = 0; b < 2; ++b)
#pragma unroll
                for (int m = 0; m < 4; ++m)
#pragma unroll
                    for (int n = 0; n < 2; ++n) acc[a][b][m][n] = (f32x4){0.f, 0.f, 0.f, 0.f};
        cur = nxt; cA = nA; cB = nB; ++ui;
        if constexpr (ALIGN_EPI) { if (wr == 1) PG8_BAR; }
    }
    PG8_WAIT_V(0);
    if constexpr (!ALIGN_EPI) { if (wr == 0) PG8_BAR; }
    PG8_BAR;
    if constexpr (Epi::AFTER_DRAIN) { E.fused(acc, cur, wr, wc, fr, fq, lds, wid, lane); S.done(cur); }
#undef PG8_SA
#undef PG8_SB
#undef PG8_STAGE
#undef PG8_LDA
#undef PG8_LDB
#undef PG8_MMA
#undef PG8_WAIT_V
#undef PG8_WAIT_L
#undef PG8_BAR
#undef PG8_SCHED
}
}

using pg8::bf16_t; using pg8::bf16x8; using pg8::f32x4; using pg8::cvt_pk_bf16;
#define LAS __attribute__((address_space(3)))
typedef unsigned u32x2 __attribute__((ext_vector_type(2)));
typedef unsigned u32x4v __attribute__((ext_vector_type(4)));
typedef unsigned long long u64;

constexpr int DM = 1024, NB = 8, SQ = 4096, NTOK = NB * SQ, DFF = 2816, INC = 3864;
constexpr int NTHR = 512;
constexpr int LDS_BYTES = 147456;

enum { I_X = 0, I_C, I_MODW, I_MODB, I_NORMG, I_W13, I_W2, I_WIN, I_LNG, I_LNB, I_GWS, I_GBS, I_PE, I_CW1, I_CW2, I_CONVW, I_WBR, I_WGATE, I_WOUT, N_IN };

constexpr size_t SZ_W13 = (size_t)5632 * 1024 * 2, SZ_W2 = (size_t)1024 * 2816 * 2;
constexpr size_t WS_W13 = 0;
constexpr size_t WS_W2 = WS_W13 + 2 * SZ_W13;
constexpr size_t WS_WIN = WS_W2 + 2 * SZ_W2;
constexpr size_t WS_WG = WS_WIN + (size_t)4096 * 1024 * 2;
constexpr size_t WS_WB = WS_WG + (size_t)3072 * 1024 * 2;
constexpr size_t WS_WO3 = WS_WB + (size_t)3072 * 512 * 2;
constexpr size_t WS_WC1 = WS_WO3 + (size_t)1024 * 3072 * 2;
constexpr size_t WS_H = WS_WC1 + (size_t)2 * 256 * 2048 * 2;
constexpr size_t WS_R1 = WS_H + (size_t)NTOK * DM * 2;
constexpr size_t SZ_R1 = (size_t)253 * 1024 * 1024 - 0;
constexpr size_t WS_R2 = WS_R1 + (size_t)241 * 1024 * 1024;
constexpr size_t WS_NG = WS_R2 + (size_t)NTOK * 1536 * 2;
constexpr size_t WS_HID = WS_NG + (size_t)NTOK * 24 * 4;
constexpr size_t WS_KC = WS_HID + (size_t)2 * 4096 * 128 * 2;
constexpr size_t WS_MOD = WS_KC + (size_t)2 * 16 * 256 * 64 * 2;
constexpr size_t WS_ROPE = WS_MOD + (size_t)2 * 8 * 9216 * 4;
constexpr size_t WS_CB1 = WS_ROPE + (size_t)4096 * 16 * 4;
constexpr size_t WS_BAR = WS_CB1 + 4096;
constexpr size_t WS_UL = WS_BAR + 16384;
constexpr size_t WS_END = WS_UL + (size_t)4 * 4096 * 256 * 4;
constexpr size_t R1_ACT = 0, R1_Y1 = (size_t)NTOK * DFF * 2;
constexpr size_t R1_AIN = 0, R1_Q = (size_t)NTOK * 1024 * 2, R1_KV = R1_Q + (size_t)NTOK * 512 * 2, R1_C = R1_KV + (size_t)6 * 16 * 4096 * 64 * 2 + 4096;
constexpr size_t R1_GATES = 0;
static_assert(R1_C + (size_t)NTOK * 1536 * 2 <= (size_t)241 * 1024 * 1024, "R1");
static_assert(R1_Y1 + (size_t)NTOK * DM * 2 <= (size_t)241 * 1024 * 1024, "R1b");
constexpr size_t KVSZ = (size_t)16 * 4096 * 64;

struct Args { const float* in[N_IN]; float* out; unsigned char* ws; };

__device__ __forceinline__ float bf2f(unsigned short v) { return __uint_as_float((unsigned)v << 16); }
__device__ __forceinline__ unsigned short f2bf(float f) { return (unsigned short)(cvt_pk_bf16(f, 0.f) & 0xffffu); }
__device__ __forceinline__ float gelu_t(float x) { const float u = 0.7978845608f * (x + 0.044715f * x * x * x); return x * __builtin_amdgcn_rcpf(1.f + __builtin_amdgcn_exp2f(-2.885390082f * u)); }
__device__ __forceinline__ float sigm(float x) { return __builtin_amdgcn_rcpf(1.f + __builtin_amdgcn_exp2f(-1.4426950408889634f * x)); }
__device__ __forceinline__ float wave_sum(float v) {
#pragma unroll
    for (int o = 32; o >= 1; o >>= 1) v += __shfl_xor(v, o);
    return v;
}

struct CmId { __device__ int operator()(int n) const { return n; } };
struct CmW13 { __device__ int operator()(int n) const { const int t = n >> 8, r = n & 255; return r < 128 ? t * 128 + r : DFF + t * 128 + (r - 128); } };
struct CmWin { __device__ int operator()(int n) const { return n < 2304 ? n : (n < 3840 ? n + 24 : (n < 3864 ? n - 3840 + 2304 : -1)); } };
struct CmC1 { __device__ int operator()(int n) const { return n < 128 ? n : -1; } };

struct TJob { const float* src; bf16_t* dst; int ld_src, ld_dst, ntk, cm; };
__device__ __forceinline__ int tj_col(int cm, int n) {
    if (cm == 1) { const int t = n >> 8, r = n & 255; return r < 128 ? t * 128 + r : DFF + t * 128 + (r - 128); }
    if (cm == 2) return n < 2304 ? n : (n < 3840 ? n + 24 : (n < 3864 ? n - 3840 + 2304 : -1));
    return n;
}
__device__ __forceinline__ void transpose_tile(const TJob& jb, int t, LAS float* tl, int otid) {
    const int j = otid & 63, i = otid >> 6;
    const int tn = t / jb.ntk, tk = t - tn * jb.ntk, n0 = tn * 64, k0 = tk * 128;
    const int sc = tj_col(jb.cm, n0 + j);
    float v[16];
#pragma unroll
    for (int kk = 0; kk < 16; ++kk) v[kk] = sc >= 0 ? jb.src[(size_t)(k0 + i + kk * 8) * jb.ld_src + sc] : 0.f;
#pragma unroll
    for (int kk = 0; kk < 16; ++kk) tl[(i + kk * 8) * 65 + j] = v[kk];
    __syncthreads();
    const int r = otid >> 3, c8 = (otid & 7) * 8;
#pragma unroll
    for (int hh = 0; hh < 2; ++hh) {
        const int cb = hh * 64 + c8;
        u32x4v w;
        w.x = cvt_pk_bf16(tl[(cb + 0) * 65 + r], tl[(cb + 1) * 65 + r]); w.y = cvt_pk_bf16(tl[(cb + 2) * 65 + r], tl[(cb + 3) * 65 + r]);
        w.z = cvt_pk_bf16(tl[(cb + 4) * 65 + r], tl[(cb + 5) * 65 + r]); w.w = cvt_pk_bf16(tl[(cb + 6) * 65 + r], tl[(cb + 7) * 65 + r]);
        *(u32x4v*)(jb.dst + (size_t)(n0 + r) * jb.ld_dst + k0 + cb) = w;
    }
    __syncthreads();
}

#define TJ_JOB(SRC, LDSRC, KK, NP, CM, DST, LDDST) { const int nt_ = ((KK) / 128) * ((NP) / 64); if (!found) { if (tt < nt_) { found = true; jb.src = (SRC); jb.dst = (DST); jb.ld_src = (LDSRC); jb.ld_dst = (LDDST); jb.ntk = (KK) / 128; jb.cm = (CM); } else tt -= nt_; } }
__device__ __forceinline__ void convert_weights(const Args& a, int l, LAS unsigned char* lds) {
    const int otid = opaque_tid();
    LAS float* tl = (LAS float*)lds;
    unsigned char* ws = a.ws;
    constexpr int TOTAL = 2 * (8 * 88) + 2 * (22 * 16) + 8 * 64 + 8 * 48 + 3 * (4 * 16) + 8 * 16 + 4 * (8 * 2);
    for (int t = blockIdx.x; t < TOTAL; t += gridDim.x) {
        int tt = t; bool found = false; TJob jb; jb.src = nullptr; jb.dst = nullptr; jb.ld_src = 0; jb.ld_dst = 0; jb.ntk = 1; jb.cm = 0;
        TJ_JOB(a.in[I_W13] + (size_t)(l * 2 + 0) * 1024 * 5632, 5632, 1024, 5632, 1, (bf16_t*)(ws + WS_W13), 1024)
        TJ_JOB(a.in[I_W13] + (size_t)(l * 2 + 1) * 1024 * 5632, 5632, 1024, 5632, 1, (bf16_t*)(ws + WS_W13 + SZ_W13), 1024)
        TJ_JOB(a.in[I_W2] + (size_t)(l * 2 + 0) * 2816 * 1024, 1024, 2816, 1024, 0, (bf16_t*)(ws + WS_W2), 2816)
        TJ_JOB(a.in[I_W2] + (size_t)(l * 2 + 1) * 2816 * 1024, 1024, 2816, 1024, 0, (bf16_t*)(ws + WS_W2 + SZ_W2), 2816)
        TJ_JOB(a.in[I_WIN] + (size_t)l * 1024 * INC, INC, 1024, 4096, 2, (bf16_t*)(ws + WS_WIN), 1024)
        TJ_JOB(a.in[I_WGATE] + (size_t)l * 1024 * 3072, 3072, 1024, 3072, 0, (bf16_t*)(ws + WS_WG), 1024)
        TJ_JOB(a.in[I_WBR] + (size_t)(l * 3 + 0) * 512 * 1024, 1024, 512, 1024, 0, (bf16_t*)(ws + WS_WB) + (size_t)0 * 1024 * 512, 512)
        TJ_JOB(a.in[I_WBR] + (size_t)(l * 3 + 1) * 512 * 1024, 1024, 512, 1024, 0, (bf16_t*)(ws + WS_WB) + (size_t)1 * 1024 * 512, 512)
        TJ_JOB(a.in[I_WBR] + (size_t)(l * 3 + 2) * 512 * 1024, 1024, 512, 1024, 0, (bf16_t*)(ws + WS_WB) + (size_t)2 * 1024 * 512, 512)
        TJ_JOB(a.in[I_WOUT] + (size_t)l * 1024 * 1024, 1024, 1024, 1024, 0, (bf16_t*)(ws + WS_WO3), 1024)
        TJ_JOB(a.in[I_CW1] + (size_t)(l * 2 + 0) * 2048 * 128, 128, 1024, 128, 0, (bf16_t*)(ws + WS_WC1), 1024)
        TJ_JOB(a.in[I_CW1] + (size_t)(l * 2 + 0) * 2048 * 128 + (size_t)1024 * 128, 128, 1024, 128, 0, (bf16_t*)(ws + WS_WC1) + (size_t)128 * 1024, 1024)
        TJ_JOB(a.in[I_CW1] + (size_t)(l * 2 + 1) * 2048 * 128, 128, 1024, 128, 0, (bf16_t*)(ws + WS_WC1) + (size_t)256 * 1024, 1024)
        TJ_JOB(a.in[I_CW1] + (size_t)(l * 2 + 1) * 2048 * 128 + (size_t)1024 * 128, 128, 1024, 128, 0, (bf16_t*)(ws + WS_WC1) + (size_t)256 * 1024 + (size_t)128 * 1024, 1024)
        transpose_tile(jb, tt, tl, otid);
    }
    const int kvb = (int)blockIdx.x - ((int)gridDim.x - 32);
    if (kvb >= 0) {
        const int kv = kvb >> 4, h0 = (kvb & 15) * 8, hh = otid & 7, ks = otid >> 3;
        const float* pe = a.in[I_PE] + (size_t)(l * 2 + kv) * 2048 + ks * 32; const float* w1 = a.in[I_CW1] + (size_t)(l * 2 + kv) * 2048 * 128 + (size_t)ks * 32 * 128 + h0 + hh;
        float s = 0.f;
#pragma unroll 8
        for (int k = 0; k < 32; ++k) s += pe[k] * w1[(size_t)k * 128];
        __syncthreads();
        tl[otid] = s;
        __syncthreads();
        if (otid < 8) { float t = 0.f; for (int q = 0; q < 64; ++q) t += tl[q * 8 + otid]; ((float*)(ws + WS_CB1))[kv * 128 + h0 + otid] = t; }
        __syncthreads();
    }
}

__device__ __forceinline__ void mod_rope_phase(const Args& a, LAS unsigned char* lds) {
    const int otid = opaque_tid();
    LAS float* sc = (LAS float*)lds;
    LAS float* red = (LAS float*)(lds + 32768);
    const int tid = otid, lane = tid & 63, w = tid >> 6;
    for (int i = tid; i < 8192; i += NTHR) { const float v = a.in[I_C][i]; sc[i] = v / (1.f + __expf(-v)); }
    __syncthreads();
    float* MOD = (float*)(a.ws + WS_MOD);
    for (int u = blockIdx.x; u < 288; u += gridDim.x) {
        const int l = u / 144, j0 = (u % 144) * 64;
        const float* mw = a.in[I_MODW] + (size_t)l * 1024 * 9216 + j0 + lane;
        float acc[8];
#pragma unroll
        for (int b = 0; b < 8; ++b) acc[b] = 0.f;
        for (int k = w * 128; k < w * 128 + 128; k += 16) {
            float wv[16];
#pragma unroll
            for (int q = 0; q < 16; ++q) wv[q] = mw[(size_t)(k + q) * 9216];
#pragma unroll
            for (int q = 0; q < 16; ++q)
#pragma unroll
                for (int b = 0; b < 8; ++b) acc[b] += sc[b * 1024 + k + q] * wv[q];
        }
#pragma unroll
        for (int b = 0; b < 8; ++b) red[(w * 8 + b) * 64 + lane] = acc[b];
        __syncthreads();
        {
            const int b = w; float s = 0.f;
#pragma unroll
            for (int sl = 0; sl < 8; ++sl) s += red[(sl * 8 + b) * 64 + lane];
            MOD[(size_t)(l * 8 + b) * 9216 + j0 + lane] = s + a.in[I_MODB][l * 9216 + j0 + lane];
        }
        __syncthreads();
    }
    float* RT = (float*)(a.ws + WS_ROPE);
    for (int i = blockIdx.x * NTHR + tid; i < 4096 * 8; i += gridDim.x * NTHR) {
        const int s = i >> 3, e = i & 7;
        const float inv = 1.0f / powf(500000.0f, (float)(2 * e) / 16.0f);
        const float ang = (float)s * inv;
        RT[i * 2] = cosf(ang); RT[i * 2 + 1] = sinf(ang);
    }
}

__device__ __forceinline__ u32x2 pack4(f32x4 v) { u32x2 o; o.x = cvt_pk_bf16(v[0], v[1]); o.y = cvt_pk_bf16(v[2], v[3]); return o; }
struct NormRows { f32x4 xv[2][4]; u32x2 yr[2][4]; };
__device__ __forceinline__ void norm_load(NormRows& R, const void* xin, bool xin_bf, const bf16_t* y, int r, int lane) {
#pragma unroll
    for (int q = 0; q < 2; ++q)
#pragma unroll
        for (int s = 0; s < 4; ++s) {
            const size_t e = (size_t)(r + q) * DM + s * 256 + lane * 4;
            if (xin_bf) { const u32x2 t = __builtin_nontemporal_load((const u32x2*)((const bf16_t*)xin + e));
                R.xv[q][s] = (f32x4){__uint_as_float(t.x << 16), __uint_as_float(t.x & 0xffff0000u), __uint_as_float(t.y << 16), __uint_as_float(t.y & 0xffff0000u)}; }
            else R.xv[q][s] = __builtin_nontemporal_load((const f32x4*)((const float*)xin + e));
            if (y) R.yr[q][s] = __builtin_nontemporal_load((const u32x2*)(y + e));
        }
}
__device__ __forceinline__ void norm_rows(NormRows& R, bool hasy, const f32x4 (&gp)[4], const f32x4 (&pa)[4], const float* mshift, int b, void* xout, bool xout_bf, bf16_t* h, int r, int lane) {
    if (hasy) {
        float ss[2];
#pragma unroll
        for (int q = 0; q < 2; ++q) { float t = 0.f;
#pragma unroll
            for (int s = 0; s < 4; ++s) { const float a0 = __uint_as_float(R.yr[q][s].x << 16), a1 = __uint_as_float(R.yr[q][s].x & 0xffff0000u), a2 = __uint_as_float(R.yr[q][s].y << 16), a3 = __uint_as_float(R.yr[q][s].y & 0xffff0000u);
                t += a0 * a0 + a1 * a1 + a2 * a2 + a3 * a3; }
            ss[q] = t; }
#pragma unroll
        for (int o = 32; o >= 1; o >>= 1)
#pragma unroll
            for (int q = 0; q < 2; ++q) ss[q] += __shfl_xor(ss[q], o);
#pragma unroll
        for (int q = 0; q < 2; ++q) { const float rs = rsqrtf(ss[q] * (1.f / DM) + 1e-6f);
#pragma unroll
            for (int s = 0; s < 4; ++s) { const f32x4 yv = (f32x4){__uint_as_float(R.yr[q][s].x << 16), __uint_as_float(R.yr[q][s].x & 0xffff0000u), __uint_as_float(R.yr[q][s].y << 16), __uint_as_float(R.yr[q][s].y & 0xffff0000u)};
                R.xv[q][s] += gp[s] * (yv * rs);
                const size_t e = (size_t)(r + q) * DM + s * 256 + lane * 4;
                if (xout_bf) { const u32x2 pk = pack4(R.xv[q][s]); *(u32x2*)((bf16_t*)xout + e) = pk;
                    R.xv[q][s] = (f32x4){__uint_as_float(pk.x << 16), __uint_as_float(pk.x & 0xffff0000u), __uint_as_float(pk.y << 16), __uint_as_float(pk.y & 0xffff0000u)}; }
                else *(f32x4*)((float*)xout + e) = R.xv[q][s]; } }
    }
    if (h) {
        float ss[2]; f32x4 ps[4];
#pragma unroll
        for (int s = 0; s < 4; ++s) ps[s] = *(const f32x4*)(mshift + b * 9216 + s * 256 + lane * 4);
#pragma unroll
        for (int q = 0; q < 2; ++q) { float t = 0.f;
#pragma unroll
            for (int s = 0; s < 4; ++s) { const f32x4 v = R.xv[q][s]; t += v[0] * v[0] + v[1] * v[1] + v[2] * v[2] + v[3] * v[3]; }
            ss[q] = t; }
#pragma unroll
        for (int o = 32; o >= 1; o >>= 1)
#pragma unroll
            for (int q = 0; q < 2; ++q) ss[q] += __shfl_xor(ss[q], o);
#pragma unroll
        for (int q = 0; q < 2; ++q) { const float rs = rsqrtf(ss[q] * (1.f / DM) + 1e-6f);
#pragma unroll
            for (int s = 0; s < 4; ++s) { const f32x4 o = R.xv[q][s] * rs * pa[s] + ps[s];
                *(u32x2*)(h + (size_t)(r + q) * DM + s * 256 + lane * 4) = pack4(o); } }
    }
}
__device__ __forceinline__ void norm_phase(const void* xin, bool xin_bf, const bf16_t* y, const float* gpost, const float* mgate, float rw,
                                           const float* gpre, const float* mshift, const float* mscale, void* xout, bool xout_bf, bf16_t* h) {
    const int otid = opaque_tid();
    const int lane = otid & 63, w = otid >> 6;
    const int nw = gridDim.x * 8, rows_per = NTOK / nw;
    const int gw = blockIdx.x * 8 + w;
    const int r0 = gw * rows_per, b = r0 / SQ;
    f32x4 gp[4], pa[4];
#pragma unroll
    for (int s = 0; s < 4; ++s) {
        const int c = s * 256 + lane * 4;
        if (y) { const f32x4 g1 = *(const f32x4*)(mgate + b * 9216 + c), g2 = *(const f32x4*)(gpost + c); gp[s] = g1 * g2 * rw; } else gp[s] = (f32x4){0.f, 0.f, 0.f, 0.f};
        if (h) { const f32x4 g1 = *(const f32x4*)(gpre + c), g2 = *(const f32x4*)(mscale + b * 9216 + c); pa[s] = g1 * (g2 + 1.f); }
        else { pa[s] = (f32x4){0.f, 0.f, 0.f, 0.f}; }
    }
    NormRows A, B;
    norm_load(A, xin, xin_bf, y, r0, lane);
    for (int r = r0; r < r0 + rows_per; r += 4) {
        norm_load(B, xin, xin_bf, y, r + 2, lane);
        norm_rows(A, y != nullptr, gp, pa, mshift, b, xout, xout_bf, h, r, lane);
        if (r + 4 < r0 + rows_per) norm_load(A, xin, xin_bf, y, r + 4, lane);
        norm_rows(B, y != nullptr, gp, pa, mshift, b, xout, xout_bf, h, r + 2, lane);
    }
}

#define EPI8(...) \
    _Pragma("unroll") for (int ai = 0; ai < 2; ++ai) _Pragma("unroll") for (int m = 0; m < 4; ++m) { const int row = u.pm * 256 + ai * 128 + wr * 64 + m * 16 + fr; \
    _Pragma("unroll") for (int bj = 0; bj < 2; ++bj) { const int c8 = bj * 128 + wc * 32 + fq * 8; const f32x4 v0 = acc[ai][bj][m][0], v1 = acc[ai][bj][m][1]; __VA_ARGS__ } }
__device__ __forceinline__ u32x4v pack8(f32x4 a, f32x4 b) { u32x4v o; o.x = cvt_pk_bf16(a[0], a[1]); o.y = cvt_pk_bf16(a[2], a[3]); o.z = cvt_pk_bf16(b[0], b[1]); o.w = cvt_pk_bf16(b[2], b[3]); return o; }
__device__ __forceinline__ f32x4 unlo(u32x4v g) { return (f32x4){__uint_as_float(g.x << 16), __uint_as_float(g.x & 0xffff0000u), __uint_as_float(g.y << 16), __uint_as_float(g.y & 0xffff0000u)}; }
__device__ __forceinline__ f32x4 unhi(u32x4v g) { return (f32x4){__uint_as_float(g.z << 16), __uint_as_float(g.z & 0xffff0000u), __uint_as_float(g.w << 16), __uint_as_float(g.w & 0xffff0000u)}; }
__device__ __forceinline__ f32x4 sig4(f32x4 v) { return (f32x4){sigm(v[0]), sigm(v[1]), sigm(v[2]), sigm(v[3])}; }
__device__ __forceinline__ f32x4 gelu4(f32x4 v) { return (f32x4){gelu_t(v[0]), gelu_t(v[1]), gelu_t(v[2]), gelu_t(v[3])}; }

struct EpiPlain {
    static constexpr bool PERM = true, AFTER_DRAIN = false;
    bf16_t* O; int ldc;
    __device__ __forceinline__ void operator()(const f32x4 (&acc)[2][2][4][2], const pg8::Unit& u, int wr, int wc, int fr, int fq) const {
        EPI8( *(u32x4v*)(O + (size_t)row * ldc + u.pn * 256 + c8) = pack8(v0, v1); )
    }
};
struct EpiSigmoid {
    static constexpr bool PERM = true, AFTER_DRAIN = false;
    bf16_t* O; int ldc;
    __device__ __forceinline__ void operator()(const f32x4 (&acc)[2][2][4][2], const pg8::Unit& u, int wr, int wc, int fr, int fq) const {
        EPI8( *(u32x4v*)(O + (size_t)row * ldc + u.pn * 256 + c8) = pack8(sig4(v0), sig4(v1)); )
    }
};
struct EpiBranchAcc {
    static constexpr bool PERM = true, AFTER_DRAIN = false;
    const bf16_t* G; bf16_t* Mg;
    __device__ __forceinline__ void operator()(const f32x4 (&acc)[2][2][4][2], const pg8::Unit& u, int wr, int wc, int fr, int fq) const {
        const int nb = u.pn >> 2, dt = u.pn & 3;
#pragma unroll
        for (int ai = 0; ai < 2; ++ai) {
            u32x4v gv[4][2], qv[4][2];
#pragma unroll
            for (int m = 0; m < 4; ++m)
#pragma unroll
                for (int bj = 0; bj < 2; ++bj) {
                    const int row = u.pm * 256 + ai * 128 + wr * 64 + m * 16 + fr, c8 = bj * 128 + wc * 32 + fq * 8;
                    gv[m][bj] = *(const u32x4v*)(G + (size_t)row * 3072 + nb * 1024 + dt * 256 + c8);
                    if (nb > 0) qv[m][bj] = *(const u32x4v*)(Mg + (size_t)row * 1024 + dt * 256 + c8); else qv[m][bj] = (u32x4v){0u, 0u, 0u, 0u};
                }
#pragma unroll
            for (int m = 0; m < 4; ++m)
#pragma unroll
                for (int bj = 0; bj < 2; ++bj) {
                    const int row = u.pm * 256 + ai * 128 + wr * 64 + m * 16 + fr, c8 = bj * 128 + wc * 32 + fq * 8;
                    f32x4 o0 = acc[ai][bj][m][0] * unlo(gv[m][bj]), o1 = acc[ai][bj][m][1] * unhi(gv[m][bj]);
                    if (nb > 0) { o0 += unlo(qv[m][bj]); o1 += unhi(qv[m][bj]); }
                    *(u32x4v*)(Mg + (size_t)row * 1024 + dt * 256 + c8) = pack8(o0, o1);
                }
        }
    }
};
struct BranchOrder {
    pg8::StaticOrder S4;
    __device__ void init(int M, int G_, int c_) { S4.init(M, 1024, G_, c_); }
    __device__ bool next(int i, pg8::Unit& u) const { const int j = i / 3, n = i - 3 * j; pg8::Unit t; if (!S4.next(j, t)) return false; u.pm = t.pm; u.pn = n * 4 + t.pn; return true; }
    __device__ __forceinline__ void a_ready(const pg8::Unit&) const {}
    __device__ __forceinline__ void done(const pg8::Unit&) const {}
};
struct EpiSwiglu {
    static constexpr bool PERM = true, AFTER_DRAIN = false;
    bf16_t* O;
    __device__ __forceinline__ void operator()(const f32x4 (&acc)[2][2][4][2], const pg8::Unit& u, int wr, int wc, int fr, int fq) const {
#pragma unroll
        for (int ai = 0; ai < 2; ++ai)
#pragma unroll
            for (int m = 0; m < 4; ++m) { const int row = u.pm * 256 + ai * 128 + wr * 64 + m * 16 + fr;
                f32x4 o[2];
#pragma unroll
                for (int n = 0; n < 2; ++n) { const f32x4 g = acc[ai][0][m][n], uu = acc[ai][1][m][n];
#pragma unroll
                    for (int j = 0; j < 4; ++j) o[n][j] = g[j] * sigm(g[j]) * uu[j]; }
                *(u32x4v*)(O + (size_t)row * DFF + u.pn * 128 + wc * 32 + fq * 8) = pack8(o[0], o[1]); }
    }
};
struct EpiWin {
    static constexpr bool PERM = true, AFTER_DRAIN = false;
    bf16_t* AIN; bf16_t* Q; bf16_t* KV; bf16_t* C; float* NG;
    __device__ __forceinline__ void operator()(const f32x4 (&acc)[2][2][4][2], const pg8::Unit& u, int wr, int wc, int fr, int fq) const {
        const int pn = u.pn;
        if (pn < 4) { EPI8( *(u32x4v*)(AIN + (size_t)row * 1024 + pn * 256 + c8) = pack8(gelu4(v0), gelu4(v1)); ) }
        else if (pn < 6) { EPI8( *(u32x4v*)(Q + (size_t)row * 512 + (pn - 4) * 256 + c8) = pack8(v0, v1); ) }
        else if (pn < 9) { EPI8( const int cc = (pn - 6) * 256 + c8; const int which = cc >> 7, g = (cc >> 6) & 1, d = cc & 63; const int b = row >> 12, s = row & 4095;
                                 *(u32x4v*)(KV + (size_t)which * KVSZ + ((size_t)(b * 2 + g) * 4096 + s) * 64 + d) = pack8(v0, v1); ) }
        else if (pn < 15) { EPI8( *(u32x4v*)(C + (size_t)row * 1536 + (pn - 9) * 256 + c8) = pack8(v0, v1); ) }
        else { EPI8( if (c8 < 24) { *(f32x4*)(NG + (size_t)row * 24 + c8) = v0; *(f32x4*)(NG + (size_t)row * 24 + c8 + 4) = v1; } ) }
    }
};
struct EpiUL {
    static constexpr bool PERM = true, AFTER_DRAIN = false;
    float* O;
    __device__ __forceinline__ void operator()(const f32x4 (&acc)[2][2][4][2], const pg8::Unit& u, int wr, int wc, int fr, int fq) const {
        EPI8( *(f32x4*)(O + (size_t)row * 256 + c8) = v0; *(f32x4*)(O + (size_t)row * 256 + c8 + 4) = v1; )
    }
};
struct EpiCmp1 {
    static constexpr bool PERM = true, AFTER_DRAIN = false;
    bf16_t* O; const float* cb;
    __device__ __forceinline__ void operator()(const f32x4 (&acc)[2][2][4][2], const pg8::Unit& u, int wr, int wc, int fr, int fq) const {
        EPI8( if (bj == 0) { const f32x4 b0 = *(const f32x4*)(cb + c8), b1 = *(const f32x4*)(cb + c8 + 4);
              *(u32x4v*)(O + (size_t)row * 128 + c8) = pack8(gelu4(v0 + b0), gelu4(v1 + b1)); } )
    }
};

template <class Epi> __device__ __forceinline__ void run_gemm(LAS unsigned char* lds, const bf16_t* A, int lda, const bf16_t* Bt, int ldb, int M, int N, int K, int adiv, int aoff, const Epi& E, int cshift = 0) {
    pg8::Gemm g; g.A = A; g.Bt = Bt; g.M = M; g.N = N; g.K = K; g.lda = lda; g.ldb = ldb; g.adiv = adiv; g.aoff = aoff;
    pg8::StaticOrder S; S.init(M, N, (int)gridDim.x, (int)((blockIdx.x + cshift) % gridDim.x));
    pg8::gemm_phase<Epi, pg8::StaticOrder, true, true>((PG8_LAS unsigned char*)lds, g, S, E);
    __syncthreads();
}

__device__ __forceinline__ void gmlp_phase(const Args& a, int l, LAS unsigned char* lds) {
    const int otid = opaque_tid();
    const bf16_t* AIN = (const bf16_t*)(a.ws + WS_R1 + R1_AIN);
    bf16_t* YS = (bf16_t*)(a.ws + WS_R2);
    LAS bf16_t* Vt = (LAS bf16_t*)lds;
    const int tid = otid, lane = tid & 63, w = tid >> 6, fr = lane & 15, fq = lane >> 4;
    const float* lng = a.in[I_LNG] + l * 512; const float* lnb = a.in[I_LNB] + l * 512;
    const int bx = (int)blockIdx.x; const bool g256 = gridDim.x == 256;
    const bool cmpblk = g256 && ((bx >= 64 && bx < 80) || (bx >= 192 && bx < 208));
    const int extra = !g256 ? -1 : (bx < 16 ? 64 + bx : ((bx >= 128 && bx < 144) ? 192 + (bx - 128) : -1));
    const int nit = (256 - bx + (int)gridDim.x - 1) / (int)gridDim.x;
    for (int ii = 0; ii < nit; ++ii) {
        const int it = bx + ii * (int)gridDim.x;
        const int row0 = it * 128;
        __syncthreads();
        for (int s8 = w * 16; s8 < w * 16 + 16; s8 += 8) {
            float x[8][8]; float sm[8], sq[8];
#pragma unroll
            for (int q = 0; q < 8; ++q) { const bf16_t* vp = AIN + (size_t)(row0 + s8 + q) * 1024 + 512;
#pragma unroll
                for (int e = 0; e < 8; ++e) x[q][e] = bf2f(vp[lane + 64 * e]); }
#pragma unroll
            for (int q = 0; q < 8; ++q) { float t = 0.f;
#pragma unroll
                for (int e = 0; e < 8; ++e) t += x[q][e];
                sm[q] = t; }
#pragma unroll
            for (int o = 32; o >= 1; o >>= 1)
#pragma unroll
                for (int q = 0; q < 8; ++q) sm[q] += __shfl_xor(sm[q], o);
#pragma unroll
            for (int q = 0; q < 8; ++q) { const float mu = sm[q] * (1.f / 512.f); sm[q] = mu; float t = 0.f;
#pragma unroll
                for (int e = 0; e < 8; ++e) { const float d = x[q][e] - mu; t += d * d; }
                sq[q] = t; }
#pragma unroll
            for (int o = 32; o >= 1; o >>= 1)
#pragma unroll
                for (int q = 0; q < 8; ++q) sq[q] += __shfl_xor(sq[q], o);
#pragma unroll
            for (int e = 0; e < 8; ++e) { const int c = lane + 64 * e; const float lg = lng[c], lb = lnb[c];
#pragma unroll
                for (int q = 0; q < 8; ++q) { const float rstd = rsqrtf(sq[q] * (1.f / 512.f) + 1e-6f); Vt[c * 136 + s8 + q] = f2bf((x[q][e] - sm[q]) * rstd * lg + lb); } }
        }
        __syncthreads();
        const int g = w >> 1, jw = w & 1;
        const float* W = a.in[I_GWS] + (size_t)(l * 4 + g) * 128 * 128;
        for (int tix = 0; tix < 4; ++tix) {
            const int T = jw == 0 ? (tix == 0 ? 0 : (tix == 1 ? 7 : (tix == 2 ? 2 : 5))) : (tix == 0 ? 1 : (tix == 1 ? 6 : (tix == 2 ? 3 : 4)));
            const int t0 = T * 16, t = t0 + fr, nkk = (T >> 1) + 1;
            const size_t row = (size_t)(row0 + t);
            f32x4 wl[4][2]; u32x2 uv[8];
#pragma unroll
            for (int kk = 0; kk < 4; ++kk) { if (kk < nkk) { wl[kk][0] = *(const f32x4*)(W + t * 128 + kk * 32 + fq * 8); wl[kk][1] = *(const f32x4*)(W + t * 128 + kk * 32 + fq * 8 + 4); }
                else { wl[kk][0] = (f32x4){0.f, 0.f, 0.f, 0.f}; wl[kk][1] = wl[kk][0]; } }
#pragma unroll
            for (int c = 0; c < 8; ++c) uv[c] = *(const u32x2*)(AIN + row * 1024 + g * 128 + c * 16 + fq * 4);
            const float bias = a.in[I_GBS][(l * 4 + g) * 128 + t];
            f32x4 acc[8];
#pragma unroll
            for (int c = 0; c < 8; ++c) acc[c] = (f32x4){0.f, 0.f, 0.f, 0.f};
#pragma unroll
            for (int kk = 0; kk < 4; ++kk) {
                if (kk < nkk) {
                    const int s0 = kk * 32 + fq * 8;
                    float wv[8] = {wl[kk][0][0], wl[kk][0][1], wl[kk][0][2], wl[kk][0][3], wl[kk][1][0], wl[kk][1][1], wl[kk][1][2], wl[kk][1][3]};
#pragma unroll
                    for (int e = 0; e < 8; ++e) wv[e] = (s0 + e <= t) ? wv[e] : 0.f;
                    u32x4v wp; wp.x = cvt_pk_bf16(wv[0], wv[1]); wp.y = cvt_pk_bf16(wv[2], wv[3]); wp.z = cvt_pk_bf16(wv[4], wv[5]); wp.w = cvt_pk_bf16(wv[6], wv[7]);
                    const bf16x8 Wf = __builtin_bit_cast(bf16x8, wp);
#pragma unroll
                    for (int c = 0; c < 8; ++c) {
                        const bf16x8 Af = *(const LAS bf16x8*)(Vt + (g * 128 + c * 16 + fr) * 136 + kk * 32 + fq * 8);
                        acc[c] = __builtin_amdgcn_mfma_f32_16x16x32_bf16(Af, Wf, acc[c], 0, 0, 0);
                    }
                }
            }
#pragma unroll
            for (int c = 0; c < 8; ++c) {
                const int col = g * 128 + c * 16 + fq * 4;
                f32x4 o;
                o[0] = __uint_as_float(uv[c].x << 16) * (acc[c][0] + bias); o[1] = __uint_as_float(uv[c].x & 0xffff0000u) * (acc[c][1] + bias);
                o[2] = __uint_as_float(uv[c].y << 16) * (acc[c][2] + bias); o[3] = __uint_as_float(uv[c].y & 0xffff0000u) * (acc[c][3] + bias);
                *(u32x2*)(YS + row * 1536 + col) = pack4(o);
            }
        }
    }
    __syncthreads();
}

__device__ __forceinline__ void conv_rope_phase(const Args& a, int l, bool do_rope) {
    const int otid = opaque_tid();
    const bf16_t* C = (const bf16_t*)(a.ws + WS_R1 + R1_C);
    bf16_t* YS = (bf16_t*)(a.ws + WS_R2);
    const float* cw = a.in[I_CONVW] + (size_t)l * 3 * 512;
    const int gt = blockIdx.x * NTHR + otid, gn = gridDim.x * NTHR;
    const int bx = (int)blockIdx.x; const bool g256 = gridDim.x == 256;
    const bool cmpblk = g256 && ((bx & 63) < 16);
    const int vb = !g256 ? bx : (bx >> 6) * 48 + (bx & 63) - 16;
    const int cgt = vb * NTHR + otid, cgn = (g256 ? 192 : (int)gridDim.x) * NTHR;
    for (int i = cmpblk ? (NTOK / 4) * 64 : cgt; i < (NTOK / 4) * 64; i += cgn) {
        const int r0 = (i >> 6) * 4, c0 = (i & 63) * 8, s0 = r0 & 4095;
        u32x4v cgv[6], xtv[6], bgv[4];
#pragma unroll
        for (int k = 0; k < 6; ++k) {
            if (k >= 2 || s0 > 0) { const bf16_t* p = C + (size_t)(r0 - 2 + k) * 1536; cgv[k] = *(const u32x4v*)(p + 512 + c0); xtv[k] = *(const u32x4v*)(p + 1024 + c0); }
            else { cgv[k] = (u32x4v){0u, 0u, 0u, 0u}; xtv[k] = cgv[k]; }
        }
#pragma unroll
        for (int q = 0; q < 4; ++q) bgv[q] = *(const u32x4v*)(C + (size_t)(r0 + q) * 1536 + c0);
        float w0[8], w1[8], w2[8];
#pragma unroll
        for (int e = 0; e < 8; ++e) { w0[e] = cw[c0 + e]; w1[e] = cw[512 + c0 + e]; w2[e] = cw[1024 + c0 + e]; }
        float hc[6][8];
#pragma unroll
        for (int k = 0; k < 6; ++k) {
            const unsigned cgw[4] = {cgv[k].x, cgv[k].y, cgv[k].z, cgv[k].w}, xtw[4] = {xtv[k].x, xtv[k].y, xtv[k].z, xtv[k].w};
#pragma unroll
            for (int e = 0; e < 4; ++e) { hc[k][2 * e] = __uint_as_float(cgw[e] << 16) * __uint_as_float(xtw[e] << 16); hc[k][2 * e + 1] = __uint_as_float(cgw[e] & 0xffff0000u) * __uint_as_float(xtw[e] & 0xffff0000u); }
        }
#pragma unroll
        for (int q = 0; q < 4; ++q) {
            const unsigned bgw[4] = {bgv[q].x, bgv[q].y, bgv[q].z, bgv[q].w};
            float o[8];
#pragma unroll
            for (int e = 0; e < 8; ++e) {
                const float bv = (e & 1) ? __uint_as_float(bgw[e >> 1] & 0xffff0000u) : __uint_as_float(bgw[e >> 1] << 16);
                o[e] = bv * (w0[e] * hc[q][e] + w1[e] * hc[q + 1][e] + w2[e] * hc[q + 2][e]);
            }
            u32x4v w; w.x = cvt_pk_bf16(o[0], o[1]); w.y = cvt_pk_bf16(o[2], o[3]); w.z = cvt_pk_bf16(o[4], o[5]); w.w = cvt_pk_bf16(o[6], o[7]);
            *(u32x4v*)(YS + (size_t)(r0 + q) * 1536 + 1024 + c0) = w;
        }
    }
    bf16_t* KV = (bf16_t*)(a.ws + WS_R1 + R1_KV);
    const float* RT = (const float*)(a.ws + WS_ROPE);
    if (do_rope) for (int i = gt; i < 2 * 16 * 4096; i += gn) {
        const int wsel = i >> 16, rem = i & 65535, s = rem & 4095;
        bf16_t* p = KV + (size_t)(wsel ? 4 : 2) * KVSZ + (size_t)rem * 64;
        const u32x4v x1 = *(const u32x4v*)p, x2 = *(const u32x4v*)(p + 8);
        const unsigned a1[4] = {x1.x, x1.y, x1.z, x1.w}, a2[4] = {x2.x, x2.y, x2.z, x2.w};
        float r1[8], r2[8];
#pragma unroll
        for (int e = 0; e < 8; ++e) {
            const float v1 = (e & 1) ? __uint_as_float(a1[e >> 1] & 0xffff0000u) : __uint_as_float(a1[e >> 1] << 16);
            const float v2 = (e & 1) ? __uint_as_float(a2[e >> 1] & 0xffff0000u) : __uint_as_float(a2[e >> 1] << 16);
            const float cs = RT[(s * 8 + e) * 2], sn = RT[(s * 8 + e) * 2 + 1];
            r1[e] = v1 * cs - v2 * sn; r2[e] = v2 * cs + v1 * sn;
        }
        u32x4v o1, o2;
        o1.x = cvt_pk_bf16(r1[0], r1[1]); o1.y = cvt_pk_bf16(r1[2], r1[3]); o1.z = cvt_pk_bf16(r1[4], r1[5]); o1.w = cvt_pk_bf16(r1[6], r1[7]);
        o2.x = cvt_pk_bf16(r2[0], r2[1]); o2.y = cvt_pk_bf16(r2[2], r2[3]); o2.z = cvt_pk_bf16(r2[4], r2[5]); o2.w = cvt_pk_bf16(r2[6], r2[7]);
        *(u32x4v*)p = o1; *(u32x4v*)(p + 8) = o2;
    }
}

__device__ __forceinline__ void cmp2_phase(const Args& a, int l, LAS unsigned char* lds) {
    const int otid = opaque_tid();
    const int lane = otid & 63, w = otid >> 6;
    const float* UL = (const float*)(a.ws + WS_UL);
    const float* CB = (const float*)(a.ws + WS_CB1);
    bf16_t* KC = (bf16_t*)(a.ws + WS_KC);
    LAS float* hb = (LAS float*)lds + w * 512;
    const int nw = gridDim.x * 8;
    const int wv = blockIdx.x * 8 + w;
    if (nw == 2048) {
#pragma unroll
        for (int q = 0; q < 4; ++q) {
            const int rr = wv + q * 2048, kv = rr >> 12, r = rr & 4095, r1 = r + 1 > 4095 ? 4095 : r + 1;
            const float* U = UL + ((size_t)kv * 4096 + r) * 256; const float* L = UL + ((size_t)kv * 4096 + r1) * 256 + 128;
            const size_t P1 = (size_t)2 * 4096 * 256;
            hb[q * 128 + lane] = gelu_t((U[lane] + U[P1 + lane]) + (L[lane] + L[P1 + lane]) + CB[kv * 128 + lane]);
            hb[q * 128 + lane + 64] = gelu_t((U[lane + 64] + U[P1 + lane + 64]) + (L[lane + 64] + L[P1 + lane + 64]) + CB[kv * 128 + lane + 64]);
        }
        __syncthreads();
        const float* w2a = a.in[I_CW2] + (size_t)(l * 2 + 0) * 128 * 64 + lane; const float* w2b = a.in[I_CW2] + (size_t)(l * 2 + 1) * 128 * 64 + lane;
        float s0 = 0.f, s1 = 0.f, s2 = 0.f, s3 = 0.f;
#pragma unroll 16
        for (int h = 0; h < 128; ++h) { const float wa = w2a[h * 64], wb = w2b[h * 64]; s0 += hb[h] * wa; s1 += hb[128 + h] * wa; s2 += hb[256 + h] * wb; s3 += hb[384 + h] * wb; }
        KC[(size_t)(wv) * 64 + lane] = f2bf(s0); KC[(size_t)(wv + 2048) * 64 + lane] = f2bf(s1); KC[(size_t)(wv + 4096) * 64 + lane] = f2bf(s2); KC[(size_t)(wv + 6144) * 64 + lane] = f2bf(s3);
        __syncthreads();
    } else {
        for (int rr = wv; rr < 2 * 4096; rr += nw) {
            const int kv = rr >> 12, r = rr & 4095, r1 = r + 1 > 4095 ? 4095 : r + 1;
            const float* U = UL + ((size_t)kv * 4096 + r) * 256; const float* L = UL + ((size_t)kv * 4096 + r1) * 256 + 128;
            const float* w2 = a.in[I_CW2] + (size_t)(l * 2 + kv) * 128 * 64 + lane;
            float s0 = 0.f;
            for (int h = 0; h < 128; ++h) s0 += gelu_t((U[h] + U[(size_t)2 * 4096 * 256 + h]) + (L[h] + L[(size_t)2 * 4096 * 256 + h]) + CB[kv * 128 + h]) * w2[h * 64];
            KC[(size_t)rr * 64 + lane] = f2bf(s0);
        }
    }
}

constexpr int KSTR = 72;
enum { M_CMP1 = 0, M_CMP2 = 1, M_SLC = 2, M_WIN = 3 };

struct AttnState {
    bf16x8 qf[2][2];
    float m[2], l[2];
    f32x4 o[2][4];
};

constexpr float ATT_THR = 6.0f;
constexpr float ATT_QS = 0.125f * 1.4426950408889634f;

typedef short s16x4 __attribute__((ext_vector_type(4)));
__device__ __forceinline__ void attn_pv(AttnState& st, const LAS bf16_t* Vt, const bf16x8 (&pf)[2][2], int fr, int fq) {
    const LAS bf16_t* vb = Vt + (4 * fq + (fr >> 2)) * KSTR + 4 * (fr & 3);
#pragma unroll
    for (int kg = 0; kg < 2; ++kg)
#pragma unroll
        for (int dt = 0; dt < 4; ++dt) {
            const s16x4 v0 = __builtin_amdgcn_ds_read_tr16_b64_v4i16((LAS s16x4*)(vb + (kg * 32) * KSTR + dt * 16));
            const s16x4 v1 = __builtin_amdgcn_ds_read_tr16_b64_v4i16((LAS s16x4*)(vb + (kg * 32 + 16) * KSTR + dt * 16));
            const bf16x8 vf = {v0[0], v0[1], v0[2], v0[3], v1[0], v1[1], v1[2], v1[3]};
#pragma unroll
            for (int ct = 0; ct < 2; ++ct) st.o[ct][dt] = __builtin_amdgcn_mfma_f32_16x16x32_bf16(vf, pf[kg][ct], st.o[ct][dt], 0, 0, 0);
        }
}

template <int MODE, bool FAST, bool DEFER>
__device__ __forceinline__ void attn_tile(AttnState& st, const LAS bf16_t* Ks, const LAS bf16_t* Vt, int jb, int tq, bool mybit, int fr, int fq, float (&imp)[16], float& prev_t3, bf16x8 (&pfo)[2][2]) {
    constexpr bool ISCMP = (MODE == M_CMP1 || MODE == M_CMP2);
    f32x4 s[2][4];
    f32x4 zinit[2];
#pragma unroll
    for (int ct = 0; ct < 2; ++ct) { const float nb_ = !FAST ? 0.f : ((MODE == M_SLC && !mybit) ? -1e30f : (st.m[ct] < -1e29f ? 0.f : -st.m[ct])); zinit[ct] = (f32x4){nb_, nb_, nb_, nb_}; }
#pragma unroll
    for (int sb = 0; sb < 4; ++sb) {
        const bf16x8 k0 = *(const LAS bf16x8*)(Ks + (sb * 16 + fr) * KSTR + fq * 8);
        const bf16x8 k1 = *(const LAS bf16x8*)(Ks + (sb * 16 + fr) * KSTR + 32 + fq * 8);
#pragma unroll
        for (int ct = 0; ct < 2; ++ct) {
            f32x4 z = zinit[ct];
            z = __builtin_amdgcn_mfma_f32_16x16x32_bf16(k0, st.qf[ct][0], z, 0, 0, 0);
            z = __builtin_amdgcn_mfma_f32_16x16x32_bf16(k1, st.qf[ct][1], z, 0, 0, 0);
            s[ct][sb] = ISCMP ? z * ATT_QS : z;
        }
    }
    unsigned vbits = 0;
    if (!FAST) {
#pragma unroll
        for (int sb = 0; sb < 4; ++sb)
#pragma unroll
            for (int j = 0; j < 4; ++j) {
                const int kidx = jb * 64 + sb * 16 + fq * 4 + j;
                bool v;
                if (ISCMP) v = (16 * kidx + 31 <= tq);
                else if (MODE == M_SLC) v = mybit && (kidx <= tq);
                else v = (kidx <= tq) && (tq - kidx < 512);
                vbits |= (v ? 1u : 0u) << (sb * 4 + j);
            }
    }
    if (MODE == M_CMP2) {
        f32x4 p[2][4];
#pragma unroll
        for (int ct = 0; ct < 2; ++ct) {
            const float il = st.l[ct] > 0.f ? 1.f / st.l[ct] : 0.f;
#pragma unroll
            for (int sb = 0; sb < 4; ++sb)
#pragma unroll
                for (int j = 0; j < 4; ++j) p[ct][sb][j] = ((vbits >> (sb * 4 + j)) & 1u) ? __builtin_amdgcn_exp2f(s[ct][sb][j] - st.m[ct]) * il : 0.f;
        }
        {
            bf16x8 pfc[2][2];
#pragma unroll
            for (int kg = 0; kg < 2; ++kg)
#pragma unroll
                for (int ct = 0; ct < 2; ++ct) { u32x4v w; w.x = cvt_pk_bf16(p[ct][2 * kg][0], p[ct][2 * kg][1]); w.y = cvt_pk_bf16(p[ct][2 * kg][2], p[ct][2 * kg][3]);
                    w.z = cvt_pk_bf16(p[ct][2 * kg + 1][0], p[ct][2 * kg + 1][1]); w.w = cvt_pk_bf16(p[ct][2 * kg + 1][2], p[ct][2 * kg + 1][3]); pfc[kg][ct] = __builtin_bit_cast(bf16x8, w); }
            attn_pv(st, Vt, pfc, fr, fq);
        }
        const int lane = fq * 16 + fr;
#pragma unroll
        for (int sb = 0; sb < 4; ++sb) {
            float A = (p[0][sb][0] + p[0][sb][1] + p[0][sb][2]) + (p[1][sb][0] + p[1][sb][1] + p[1][sb][2]);
            float B = p[0][sb][3] + p[1][sb][3];
            A += __shfl_xor(A, 8); B += __shfl_xor(B, 8);
            const float xa = __shfl(B, (lane + 48) & 63), xb = __shfl(prev_t3, (lane + 48) & 63);
            const float pv = fq == 0 ? xb : xa;
            const float ival = A + 0.5f * B + 0.5f * pv;
#pragma unroll
            for (int T = 0; T < 4; ++T) if (jb == T) imp[T * 4 + sb] = ival;
            prev_t3 = B;
        }
        return;
    }
    if (FAST) {
        float tz[2]; bool nd[2]; bool un[2];
#pragma unroll
        for (int ct = 0; ct < 2; ++ct) {
            float t = -1e30f;
#pragma unroll
            for (int sb = 0; sb < 4; ++sb)
#pragma unroll
                for (int j = 0; j < 4; ++j) t = fmaxf(t, s[ct][sb][j]);
            t = fmaxf(t, __shfl_xor(t, 16)); t = fmaxf(t, __shfl_xor(t, 32));
            tz[ct] = t; un[ct] = st.m[ct] < -1e29f;
            nd[ct] = (t > -1e29f) && (t > ATT_THR || un[ct]);
        }
        if (__builtin_amdgcn_ballot_w64(nd[0] || nd[1]) != 0ull) {
#pragma unroll
            for (int ct = 0; ct < 2; ++ct) {
                const float dl = nd[ct] ? tz[ct] : 0.f;
                const float alpha = nd[ct] ? (un[ct] ? 0.f : __builtin_amdgcn_exp2f(-tz[ct])) : 1.f;
                st.m[ct] = nd[ct] ? ((un[ct] ? 0.f : st.m[ct]) + tz[ct]) : st.m[ct];
                st.l[ct] *= alpha;
#pragma unroll
                for (int dt = 0; dt < 4; ++dt) st.o[ct][dt] = st.o[ct][dt] * alpha;
#pragma unroll
                for (int sb = 0; sb < 4; ++sb) s[ct][sb] = s[ct][sb] - dl;
            }
        }
#pragma unroll
        for (int ct = 0; ct < 2; ++ct) {
            float ls = 0.f;
#pragma unroll
            for (int sb = 0; sb < 4; ++sb)
#pragma unroll
                for (int j = 0; j < 4; ++j) { const float pe = __builtin_amdgcn_exp2f(s[ct][sb][j]); s[ct][sb][j] = pe; ls += pe; }
            st.l[ct] += ls;
        }
    } else {
    float tmaxv[2]; bool need[2];
#pragma unroll
    for (int ct = 0; ct < 2; ++ct) {
        float tmax = -1e30f;
#pragma unroll
        for (int sb = 0; sb < 4; ++sb)
#pragma unroll
            for (int j = 0; j < 4; ++j) {
                if (!FAST) s[ct][sb][j] = ((vbits >> (sb * 4 + j)) & 1u) ? s[ct][sb][j] : -1e30f;
                tmax = fmaxf(tmax, s[ct][sb][j]);
            }
        if (FAST && MODE == M_SLC) tmax = mybit ? tmax : -1e30f;
        tmax = fmaxf(tmax, __shfl_xor(tmax, 16)); tmax = fmaxf(tmax, __shfl_xor(tmax, 32));
        tmaxv[ct] = tmax; need[ct] = tmax > st.m[ct] + ATT_THR;
    }
    if (__builtin_amdgcn_ballot_w64(need[0] || need[1]) != 0ull) {
#pragma unroll
        for (int ct = 0; ct < 2; ++ct) {
            const float alpha = need[ct] ? __builtin_amdgcn_exp2f(st.m[ct] - tmaxv[ct]) : 1.f;
            st.m[ct] = need[ct] ? tmaxv[ct] : st.m[ct];
            st.l[ct] *= alpha;
            if (MODE != M_CMP1) {
#pragma unroll
                for (int dt = 0; dt < 4; ++dt) st.o[ct][dt] = st.o[ct][dt] * alpha;
            }
        }
    }
#pragma unroll
    for (int ct = 0; ct < 2; ++ct) {
        const float mu = (FAST && MODE == M_SLC && !mybit) ? 1e30f : st.m[ct];
        float ls = 0.f;
#pragma unroll
        for (int sb = 0; sb < 4; ++sb)
#pragma unroll
            for (int j = 0; j < 4; ++j) {
                float pe = __builtin_amdgcn_exp2f(s[ct][sb][j] - mu);
                if (!FAST) pe = ((vbits >> (sb * 4 + j)) & 1u) ? pe : 0.f;
                s[ct][sb][j] = pe; ls += pe;
            }
        st.l[ct] += ls;
    }
    }
    if (MODE != M_CMP1) {
#pragma unroll
        for (int kg = 0; kg < 2; ++kg)
#pragma unroll
            for (int ct = 0; ct < 2; ++ct) { u32x4v w; w.x = cvt_pk_bf16(s[ct][2 * kg][0], s[ct][2 * kg][1]); w.y = cvt_pk_bf16(s[ct][2 * kg][2], s[ct][2 * kg][3]);
                w.z = cvt_pk_bf16(s[ct][2 * kg + 1][0], s[ct][2 * kg + 1][1]); w.w = cvt_pk_bf16(s[ct][2 * kg + 1][2], s[ct][2 * kg + 1][3]); pfo[kg][ct] = __builtin_bit_cast(bf16x8, w); }
        if (!DEFER) attn_pv(st, Vt, pfo, fr, fq);
    }
}

template <int MODE>
__device__ __forceinline__ void attn_branch(AttnState& st, const bf16_t* __restrict__ Kg, const bf16_t* __restrict__ Vg, u64 tiles, LAS bf16_t* KsB, LAS bf16_t* VtB,
                                            int tq, u64 mymask, int cur, int fr, int fq, float (&imp)[16]) {
    const int otid = opaque_tid();
    const int tid = otid;
    const int kkey = tid >> 3, kch = tid & 7;
    const bool late = false;
    float prev_t3 = 0.f;
    if (tiles == 0ull) return;
    int jb = __builtin_ctzll(tiles); tiles &= tiles - 1ull;
    u32x4v kr = *(const u32x4v*)(Kg + (size_t)(jb * 64 + kkey) * 64 + kch * 8), vr = (u32x4v){0u, 0u, 0u, 0u};
    if (MODE != M_CMP1) vr = *(const u32x4v*)(Vg + (size_t)(jb * 64 + kkey) * 64 + kch * 8);
    int pb = 0, vb = 0, vprev = 0; bool have = false;
    bf16x8 pf[2][2];
    for (;;) {
        LAS bf16_t* Ks = KsB + pb * (64 * KSTR); LAS bf16_t* Vt = VtB + vb * (64 * KSTR);
        *(LAS u32x4v*)(Ks + kkey * KSTR + kch * 8) = kr;
        if (MODE != M_CMP1) *(LAS u32x4v*)(Vt + kkey * KSTR + kch * 8) = vr;
        int jn = -1;
        if (tiles != 0ull) { jn = __builtin_ctzll(tiles); tiles &= tiles - 1ull;
            kr = *(const u32x4v*)(Kg + (size_t)(jn * 64 + kkey) * 64 + kch * 8);
            if (MODE != M_CMP1) vr = *(const u32x4v*)(Vg + (size_t)(jn * 64 + kkey) * 64 + kch * 8); }
        __syncthreads();
        if (late && have) { attn_pv(st, VtB + vprev * (64 * KSTR), pf, fr, fq); have = false; }
        const bool mybit = (mymask >> jb) & 1ull;
        bool active = true;
        if (MODE == M_SLC) active = __builtin_amdgcn_ballot_w64(mybit) != 0ull;
        if (active) {
            if (MODE == M_SLC || MODE == M_WIN) {
                const bool fast = (MODE == M_SLC) ? (jb != cur) : (jb != cur && jb != cur - 8);
                if (fast) attn_tile<MODE, true, true>(st, Ks, Vt, jb, tq, mybit, fr, fq, imp, prev_t3, pf); else attn_tile<MODE, false, true>(st, Ks, Vt, jb, tq, mybit, fr, fq, imp, prev_t3, pf);
                if (late) { have = true; vprev = vb; } else attn_pv(st, Vt, pf, fr, fq);
            } else attn_tile<MODE, false, false>(st, Ks, Vt, jb, tq, mybit, fr, fq, imp, prev_t3, pf);
        }
        if (jn < 0) break;
        jb = jn; pb ^= 1; vb = vb == 2 ? 0 : vb + 1;
    }
    if (late && have) attn_pv(st, VtB + vprev * (64 * KSTR), pf, fr, fq);
    __syncthreads();
}

__device__ __forceinline__ void attn_phase(const Args& a, LAS unsigned char* lds) {
    const int otid = opaque_tid();
    const bf16_t* Q = (const bf16_t*)(a.ws + WS_R1 + R1_Q);
    const bf16_t* KV = (const bf16_t*)(a.ws + WS_R1 + R1_KV);
    const bf16_t* KC = (const bf16_t*)(a.ws + WS_KC);
    const float* NG = (const float*)(a.ws + WS_NG);
    const float* RT = (const float*)(a.ws + WS_ROPE);
    bf16_t* YS = (bf16_t*)(a.ws + WS_R2);
    LAS bf16_t* Ks = (LAS bf16_t*)lds;
    LAS bf16_t* Vt = (LAS bf16_t*)(lds + 2 * 64 * KSTR * 2);
    LAS u64* um = (LAS u64*)(lds + 5 * 64 * KSTR * 2);
    const int tid = otid, lane = tid & 63, w = tid >> 6, fr = lane & 15, fq = lane >> 4;
    for (int i = blockIdx.x; i < 1024; i += gridDim.x) {
        const int c = i & 255, itn = i >> 8, bg = (c & 7) * 2 + (c >> 7), mm = (c >> 3) & 15;
        const int qb = itn == 0 ? mm : (itn == 1 ? 31 - mm : (itn == 2 ? 32 + mm : 63 - mm));
        const int b = bg >> 1, g = bg & 1, q0 = qb * 64, cur = qb;
        const int tq = q0 + 8 * w + (fr & 7);
        const size_t row = (size_t)b * SQ + tq;
        AttnState st;
        LAS float* oacc = (LAS float*)(lds + 49152) + tid;
        float imp[16];
#pragma unroll
        for (int k = 0; k < 16; ++k) imp[k] = 0.f;
#pragma unroll
        for (int ct = 0; ct < 2; ++ct) { const int h = g * 4 + 2 * ct + (fr >> 3);
#pragma unroll
            for (int kk = 0; kk < 2; ++kk) st.qf[ct][kk] = __builtin_bit_cast(bf16x8, *(const u32x4v*)(Q + row * 512 + h * 64 + kk * 32 + fq * 8)); }
        const bf16_t* kc = KC + (size_t)bg * 256 * 64; const bf16_t* vc = KC + (size_t)(16 + bg) * 256 * 64;
#pragma unroll
        for (int ct = 0; ct < 2; ++ct) { st.m[ct] = -1e30f; st.l[ct] = 0.f;
#pragma unroll
            for (int dt = 0; dt < 4; ++dt) st.o[ct][dt] = (f32x4){0.f, 0.f, 0.f, 0.f}; }
        const int ncmp = (q0 + 32) / 1024 + 1;
        const u64 cmpt = (1ull << (ncmp > 4 ? 4 : ncmp)) - 1ull;
        attn_branch<M_CMP1>(st, kc, vc, cmpt, Ks, Vt, tq, 0ull, cur, fr, fq, imp);
#pragma unroll
        for (int ct = 0; ct < 2; ++ct) { float lt = st.l[ct]; lt += __shfl_xor(lt, 16); lt += __shfl_xor(lt, 32); st.l[ct] = lt; }
        attn_branch<M_CMP2>(st, kc, vc, cmpt, Ks, Vt, tq, 0ull, cur, fr, fq, imp);
        {
#pragma unroll
            for (int ct = 0; ct < 2; ++ct) { const int h = g * 4 + 2 * ct + (fr >> 3); const float gt = sigm(NG[row * 24 + h * 3 + 0]);
#pragma unroll
                for (int dt = 0; dt < 4; ++dt)
#pragma unroll
                    for (int j = 0; j < 4; ++j) oacc[((ct * 4 + dt) * 4 + j) * 512] = st.o[ct][dt][j] * gt; }
        }
        u64 mymask = 0ull;
        if (cur < 16) mymask = (2ull << cur) - 1ull;
        else {
            float sc[16]; int rank[16];
#pragma unroll
            for (int k = 0; k < 16; ++k) { const int jb = 4 * k + fq; const bool forced = (jb == 0) || (jb == cur) || (jb == cur - 1);
                sc[k] = forced ? 1e4f : (jb <= cur ? imp[k] : -1.f); rank[k] = 0; }
#pragma unroll 1
            for (int f2 = 0; f2 < 4; ++f2)
#pragma unroll
                for (int k2 = 0; k2 < 16; ++k2) {
                    const float ov = __shfl(sc[k2], fr + 16 * f2); const int ob = 4 * k2 + f2;
#pragma unroll
                    for (int k = 0; k < 16; ++k) { const int jb = 4 * k + fq; rank[k] += ((ov > sc[k]) || (ov == sc[k] && ob < jb)) ? 1 : 0; }
                }
#pragma unroll
            for (int k = 0; k < 16; ++k) { const int jb = 4 * k + fq; if (rank[k] < 16 && jb <= cur) mymask |= 1ull << jb; }
            mymask |= __shfl_xor(mymask, 16); mymask |= __shfl_xor(mymask, 32);
        }
        u64 un = mymask;
        un |= __shfl_xor(un, 1); un |= __shfl_xor(un, 2); un |= __shfl_xor(un, 4);
        __syncthreads();
        { const int t2 = opaque_tid(); if ((t2 & 63) == 0) um[t2 >> 6] = un; }
        __syncthreads();
        u64 bun = 0ull;
#pragma unroll
        for (int k = 0; k < 8; ++k) bun |= um[k];
        {
            float cs[8], sn[8];
#pragma unroll
            for (int e = 0; e < 8; ++e) { cs[e] = RT[(tq * 8 + e) * 2]; sn[e] = RT[(tq * 8 + e) * 2 + 1]; }
#pragma unroll
            for (int ct = 0; ct < 2; ++ct)
#pragma unroll
                for (int kk = 0; kk < 2; ++kk) {
                    const int hq = g * 4 + 2 * ct + (fr >> 3);
                    const u32x4v qv = *(const u32x4v*)(Q + row * 512 + hq * 64 + kk * 32 + fq * 8);
                    const unsigned qw[4] = {qv.x, qv.y, qv.z, qv.w};
                    float r[8];
#pragma unroll
                    for (int e = 0; e < 8; ++e) {
                        const float x = (e & 1) ? __uint_as_float(qw[e >> 1] & 0xffff0000u) : __uint_as_float(qw[e >> 1] << 16);
                        if (kk == 0) { const float ot = __shfl_xor(x, 16); r[e] = (fq == 0 ? x * cs[e] - ot * sn[e] : (fq == 1 ? x * cs[e] + ot * sn[e] : x)) * ATT_QS; }
                        else r[e] = x * ATT_QS;
                    }
                    u32x4v o; o.x = cvt_pk_bf16(r[0], r[1]); o.y = cvt_pk_bf16(r[2], r[3]); o.z = cvt_pk_bf16(r[4], r[5]); o.w = cvt_pk_bf16(r[6], r[7]);
                    st.qf[ct][kk] = __builtin_bit_cast(bf16x8, o);
                }
        }
#pragma unroll
        for (int ct = 0; ct < 2; ++ct) { st.m[ct] = -1e30f; st.l[ct] = 0.f;
#pragma unroll
            for (int dt = 0; dt < 4; ++dt) st.o[ct][dt] = (f32x4){0.f, 0.f, 0.f, 0.f}; }
        attn_branch<M_SLC>(st, KV + 2 * KVSZ + (size_t)bg * 4096 * 64, KV + 3 * KVSZ + (size_t)bg * 4096 * 64, bun, Ks, Vt, tq, mymask, cur, fr, fq, imp);
#pragma unroll
        for (int ct = 0; ct < 2; ++ct) { const int h = g * 4 + 2 * ct + (fr >> 3); float lt = st.l[ct]; lt += __shfl_xor(lt, 16); lt += __shfl_xor(lt, 32);
            const float gt = sigm(NG[row * 24 + h * 3 + 1]) * (lt > 0.f ? 1.f / lt : 0.f);
#pragma unroll
            for (int dt = 0; dt < 4; ++dt)
#pragma unroll
                for (int j = 0; j < 4; ++j) oacc[((ct * 4 + dt) * 4 + j) * 512] += st.o[ct][dt][j] * gt; }
#pragma unroll
        for (int ct = 0; ct < 2; ++ct) { st.m[ct] = -1e30f; st.l[ct] = 0.f;
#pragma unroll
            for (int dt = 0; dt < 4; ++dt) st.o[ct][dt] = (f32x4){0.f, 0.f, 0.f, 0.f}; }
        {
            const int lo = cur - 8 < 0 ? 0 : cur - 8;
            const u64 hi_m = cur == 63 ? ~0ull : ((1ull << (cur + 1)) - 1ull);
            const u64 wt = hi_m & ~((1ull << lo) - 1ull);
            attn_branch<M_WIN>(st, KV + 4 * KVSZ + (size_t)bg * 4096 * 64, KV + 5 * KVSZ + (size_t)bg * 4096 * 64, wt, Ks, Vt, tq, 0ull, cur, fr, fq, imp);
        }
#pragma unroll
        for (int ct = 0; ct < 2; ++ct) { const int h = g * 4 + 2 * ct + (fr >> 3); float lt = st.l[ct]; lt += __shfl_xor(lt, 16); lt += __shfl_xor(lt, 32);
            const float gt = sigm(NG[row * 24 + h * 3 + 2]) * (lt > 0.f ? 1.f / lt : 0.f);
#pragma unroll
            for (int dt = 0; dt < 4; ++dt) { f32x4 v;
#pragma unroll
                for (int j = 0; j < 4; ++j) v[j] = oacc[((ct * 4 + dt) * 4 + j) * 512] + st.o[ct][dt][j] * gt;
                *(u32x2*)(YS + row * 1536 + 512 + h * 64 + dt * 16 + fq * 4) = pack4(v); } }
    }
    __syncthreads();
}
#define XB_TMO      128
#define XB_XCNT(j)  (256  + 64 * (j))
#define XB_XSUB(j)  (1280 + 64 * (j))
#define XB_XGEN(j)  (2304 + 64 * (j))
#define XB_TOP      3328
#define XB_TOPGEN   3392
#define XCD_BAR_WORDS 3456
#define XB_SPIN_CAP (1u << 18)

__device__ __forceinline__ unsigned xb_ld(unsigned* p)              { return __hip_atomic_load(p, __ATOMIC_RELAXED, __HIP_MEMORY_SCOPE_AGENT); }
__device__ __forceinline__ unsigned xb_add(unsigned* p, unsigned v) { return __hip_atomic_fetch_add(p, v, __ATOMIC_RELAXED, __HIP_MEMORY_SCOPE_AGENT); }
__device__ __forceinline__ unsigned xb_xcc_id() { return (unsigned)__builtin_amdgcn_s_getreg((3 << 11) | 20) & 0xFu; }
#define XB_SPIN(cond, bar) do { unsigned _sp = 0; while (cond) { __builtin_amdgcn_s_sleep(1); \
    if ((++_sp & 255u) == 0u) { if (xb_ld(&(bar)[XB_TMO])) break; if (_sp > XB_SPIN_CAP) { atomicAdd(&(bar)[XB_TMO], 1u); break; } } } } while (0)

struct XcdBarrier {
    unsigned* bar; unsigned x;
    volatile LAS unsigned* st;
};

__device__ __forceinline__ XcdBarrier xcd_barrier_post(unsigned* bar, volatile LAS unsigned* st) {
    XcdBarrier b; b.bar = bar; b.x = xb_xcc_id(); b.st = st;
    if (threadIdx.x == 0) (void)xb_add(&bar[XB_XCNT(b.x)], 1u);
    return b;
}
__device__ __forceinline__ void xcd_barrier_complete(unsigned* bar, unsigned x, unsigned& nloc, unsigned& nx) {
    const unsigned G = gridDim.x * gridDim.y * gridDim.z;
    unsigned sum, cnt, mine, sp = 0u;
    for (;;) {
        sum = 0u; cnt = 0u; mine = 0u;
#pragma unroll
        for (unsigned j = 0; j < 16; ++j) { const unsigned c = xb_ld(&bar[XB_XCNT(j)]); sum += c; cnt += (c > 0u) ? 1u : 0u; mine = (j == x) ? c : mine; }
        if (sum == G) break;
        __builtin_amdgcn_s_sleep(1);
        if ((++sp & 255u) == 0u) { if (xb_ld(&bar[XB_TMO])) break; if (sp > XB_SPIN_CAP) { atomicAdd(&bar[XB_TMO], 1u); break; } }
    }
    nloc = mine > 0u ? mine : 1u; nx = cnt > 0u ? cnt : 1u;
}

__device__ __forceinline__ void xcd_barrier(const XcdBarrier& b) {
    asm volatile("s_waitcnt vmcnt(0)" ::: "memory");
    __syncthreads();
    if (threadIdx.x == 0) {
        unsigned* bar = b.bar;
        __builtin_amdgcn_s_waitcnt(0);
        unsigned nloc = b.st[0], nx = b.st[1];
        if (nloc == 0u) { xcd_barrier_complete(bar, b.x, nloc, nx); b.st[0] = nloc; b.st[1] = nx; }
        const unsigned old = xb_add(&bar[XB_XSUB(b.x)], 1u);
        const unsigned gen = old / nloc;
        if (old + 1u == (gen + 1u) * nloc) {
            __builtin_amdgcn_fence(__ATOMIC_RELEASE, "agent");
            asm volatile("s_waitcnt vmcnt(0)" ::: "memory");
            const unsigned og = xb_add(&bar[XB_TOP], 1u);
            const unsigned tg = og / nx;
            if (og + 1u == (tg + 1u) * nx) xb_add(&bar[XB_TOPGEN], 1u);
            else XB_SPIN(xb_ld(&bar[XB_TOPGEN]) == tg, bar);
            __builtin_amdgcn_fence(__ATOMIC_ACQUIRE, "agent");
            xb_add(&bar[XB_XGEN(b.x)], 1u);
            asm volatile("s_waitcnt vmcnt(0)" ::: "memory");
        } else {
            XB_SPIN(xb_ld(&bar[XB_XGEN(b.x)]) == gen, bar);
            __builtin_amdgcn_fence(__ATOMIC_ACQUIRE, "agent");
            asm volatile("s_waitcnt vmcnt(0)" ::: "memory");
        }
    }
    __syncthreads();
}

#ifndef REP_SYNC
#define REP_SYNC 1
#endif
#ifndef USE_CG
#define USE_CG 0
#endif
#define GSYNC() do { for (int rs_ = 0; rs_ < REP_SYNC; ++rs_) { if (USE_CG) grid.sync(); else xcd_barrier(xbar); } } while (0)
#ifndef PROBE_NORM
#define PROBE_NORM 0
#endif
#ifndef PROBE_CB
#define PROBE_CB 0
#endif
#ifndef REP_ATTN
#define REP_ATTN 1
#endif
#ifndef REP_FFN
#define REP_FFN 1
#endif
#ifndef REP_MIXG
#define REP_MIXG 1
#endif
#ifndef REP_SMALL
#define REP_SMALL 1
#endif
#ifndef REP_PRO
#define REP_PRO 1
#endif
__global__ void __launch_bounds__(NTHR) mega_fwd(Args a) {
    extern __shared__ __attribute__((aligned(16))) unsigned char lds_raw[];
    LAS unsigned char* lds = (LAS unsigned char*)lds_raw;
    cg::grid_group grid = cg::this_grid();
    unsigned char* ws = a.ws;
    bf16_t* H = (bf16_t*)(ws + WS_H);
    bf16_t* ACT = (bf16_t*)(ws + WS_R1 + R1_ACT);
    bf16_t* Y1 = (bf16_t*)(ws + WS_R1 + R1_Y1);
    bf16_t* Y2 = (bf16_t*)(ws + WS_R2);
    bf16_t* GATES = (bf16_t*)(ws + WS_R1 + R1_GATES);
    bf16_t* YS = (bf16_t*)(ws + WS_R2);
    const float* MOD = (const float*)(ws + WS_MOD);
    const float* NG_ = a.in[I_NORMG];

    volatile LAS unsigned* xst = (volatile LAS unsigned*)(lds + LDS_BYTES - 16);
    if (threadIdx.x == 0) { xst[0] = 0u; xst[1] = 0u; xst[2] = 0u; xst[3] = 0u; }
    __syncthreads();
    XcdBarrier xbar = xcd_barrier_post((unsigned*)(ws + WS_BAR), xst);
    for (int rep = 0; rep < REP_PRO; ++rep) {
    convert_weights(a, 0, lds);
    __syncthreads();
    mod_rope_phase(a, lds);
    if (a.ws == nullptr) grid.sync();
    GSYNC();
    }
    norm_phase(a.in[I_X], false, nullptr, nullptr, nullptr, 0.f, NG_ + 0 * DM, MOD + 0 * DM, MOD + 1 * DM, nullptr, false, H);
    GSYNC();
#pragma unroll 1
    for (int hl = 0; hl < 4; ++hl) {
        const int l = hl >> 1, f = hl & 1;
        const float* ng = NG_ + (size_t)l * 6 * DM;
        const float* mod = MOD + (size_t)l * 8 * 9216;
        for (int rep = 0; rep < REP_FFN; ++rep) {
        { EpiSwiglu E; E.O = ACT; run_gemm(lds, H, 1024, (const bf16_t*)(ws + WS_W13 + f * SZ_W13), 1024, NTOK, 5632, 1024, 1 << 20, 0, E); }
        GSYNC();
        { EpiPlain E; E.O = Y1; E.ldc = DM; run_gemm(lds, ACT, DFF, (const bf16_t*)(ws + WS_W2 + f * SZ_W2), DFF, NTOK, 1024, DFF, 1 << 20, 0, E); }
        GSYNC();
        }
        if (f == 0) {
            norm_phase(l == 0 ? (const void*)a.in[I_X] : (const void*)a.out, l != 0, Y1, ng + 1 * DM, mod + 2 * DM, 0.5f, ng + 2 * DM, mod + 3 * DM, mod + 4 * DM, a.out, true, H);
            GSYNC();
            for (int rep = 0; rep < REP_MIXG; ++rep) {
            { EpiWin E; E.AIN = (bf16_t*)(ws + WS_R1 + R1_AIN); E.Q = (bf16_t*)(ws + WS_R1 + R1_Q); E.KV = (bf16_t*)(ws + WS_R1 + R1_KV); E.C = (bf16_t*)(ws + WS_R1 + R1_C); E.NG = (float*)(ws + WS_NG);
              run_gemm(lds, H, 1024, (const bf16_t*)(ws + WS_WIN), 1024, NTOK, 4096, 1024, 1 << 20, 0, E); }
            GSYNC();
            }
            for (int rep = 0; rep < REP_SMALL; ++rep) gmlp_phase(a, l, lds);
            if (PROBE_CB) conv_rope_phase(a, l, false);
            conv_rope_phase(a, l, true);
            for (int rep = 0; rep < REP_SMALL; ++rep)
            for (int kk2 = 0; kk2 < 4; ++kk2) {
                const int kv = kk2 >> 1, kh = kk2 & 1;
                EpiUL E; E.O = (float*)(ws + WS_UL) + (size_t)(kh * 2 + kv) * 4096 * 256;
                run_gemm(lds, (const bf16_t*)(ws + WS_R1 + R1_KV) + (size_t)kv * KVSZ + kh * 512, 1024, (const bf16_t*)(ws + WS_WC1) + (size_t)kv * 256 * 1024 + kh * 512, 1024, 4096, 256, 512, 1 << 20, 0, E, 64 * kk2);
            }
            GSYNC();
            for (int rep = 0; rep < REP_SMALL; ++rep) cmp2_phase(a, l, lds);
            GSYNC();
            for (int rep = 0; rep < REP_ATTN; ++rep) {
            attn_phase(a, lds);
            GSYNC();
            }
            for (int rep = 0; rep < REP_MIXG; ++rep) {
            { EpiSigmoid E; E.O = GATES; E.ldc = 3072; run_gemm(lds, H, 1024, (const bf16_t*)(ws + WS_WG), 1024, NTOK, 3072, 1024, 1 << 20, 0, E); }
            GSYNC();
            }
            { EpiBranchAcc E; E.G = GATES; E.Mg = H;
              pg8::Gemm g; g.A = YS; g.Bt = (const bf16_t*)(ws + WS_WB); g.M = NTOK; g.N = 3072; g.K = 512; g.lda = 1536; g.ldb = 512; g.adiv = 4; g.aoff = 512;
              BranchOrder S; S.init(NTOK, (int)gridDim.x, (int)blockIdx.x);
              pg8::gemm_phase<EpiBranchAcc, BranchOrder, true, true>((PG8_LAS unsigned char*)lds, g, S, E);
              __syncthreads(); }
            GSYNC();
            for (int rep = 0; rep < REP_MIXG; ++rep) {
            { EpiPlain E; E.O = Y2; E.ldc = DM; run_gemm(lds, H, 1024, (const bf16_t*)(ws + WS_WO3), 1024, NTOK, 1024, 1024, 1 << 20, 0, E); }
            GSYNC();
            }
            norm_phase(a.out, true, Y2, ng + 3 * DM, mod + 5 * DM, 1.0f, ng + 4 * DM, mod + 6 * DM, mod + 7 * DM, l == 0 ? (void*)a.out : (void*)Y2, true, H);
            GSYNC();
        } else {
            if (l == 0) {
                norm_phase(a.out, true, Y1, ng + 5 * DM, mod + 8 * DM, 0.5f, NG_ + (size_t)6 * DM, MOD + (size_t)8 * 9216 + 0 * DM, MOD + (size_t)8 * 9216 + 1 * DM, a.out, true, H);
                convert_weights(a, 1, lds);
            } else {
                norm_phase(Y2, true, Y1, ng + 5 * DM, mod + 8 * DM, 0.5f, nullptr, nullptr, nullptr, a.out, false, nullptr);
            }
            GSYNC();
        }
    }
}

extern "C" void kernel_launch(void* const* d_in, const int* in_sizes, int n_in, void* d_out, int out_size, void* d_ws, size_t ws_size, hipStream_t stream) {
    static int grid = 0;
    if (grid == 0) {
        if (n_in != N_IN || ws_size < WS_END) { fprintf(stderr, "kernel_launch: bad n_in %d or ws_size %zu (need %zu)\n", n_in, ws_size, (size_t)WS_END); grid = -1; return; }
        int dev = 0, cus = 0, per_cu = 0;
        hipGetDevice(&dev);
        hipDeviceGetAttribute(&cus, hipDeviceAttributeMultiprocessorCount, dev);
        if (hipFuncSetAttribute((const void*)mega_fwd, hipFuncAttributeMaxDynamicSharedMemorySize, LDS_BYTES) != hipSuccess) { fprintf(stderr, "kernel_launch: hipFuncSetAttribute failed\n"); grid = -1; return; }
        hipOccupancyMaxActiveBlocksPerMultiprocessor(&per_cu, (const void*)mega_fwd, NTHR, LDS_BYTES);
        (void)hipGetLastError();
        if (per_cu < 1) per_cu = 1;
        grid = cus * 1;
        fprintf(stderr, "kernel_launch: cus %d per_cu %d grid %d\n", cus, per_cu, grid);
    }
    if (grid < 0) return;
    if (hipMemsetAsync((unsigned char*)d_ws + WS_BAR, 0, XCD_BAR_WORDS * 4, stream) != hipSuccess) { fprintf(stderr, "kernel_launch: memset failed\n"); return; }
    Args a{};
    for (int i = 0; i < N_IN; ++i) a.in[i] = (const float*)d_in[i];
    a.out = (float*)d_out; a.ws = (unsigned char*)d_ws;
    void* args[] = {&a};
    hipError_t e = hipLaunchCooperativeKernel((const void*)mega_fwd, dim3(grid), dim3(NTHR), args, LDS_BYTES, stream);
    if (e != hipSuccess) fprintf(stderr, "cooperative launch failed: %s (grid %d)\n", hipGetErrorString(e), grid);
}
```

```cpp
#include <hip/hip_runtime.h>
#include <hip/hip_cooperative_groups.h>
#include <cstdio>
#include <cstdint>
namespace cg = cooperative_groups;
__device__ __forceinline__ int opaque_tid() { int t = (int)threadIdx.x; asm volatile("" : "+v"(t)); return t; }
namespace pg8 {
#define PG8_LAS __attribute__((address_space(3)))
typedef unsigned short bf16_t;
typedef short bf16x8 __attribute__((ext_vector_type(8)));
typedef float f32x4 __attribute__((ext_vector_type(4)));
typedef unsigned u32x4 __attribute__((ext_vector_type(4)));
constexpr int BM = 256, BK = 64, HALF = 128, HTB = HALF * BK * 2  , STAGE_BYTES = 8 * HTB, NXCD = 8, WGM = 4;

__host__ __device__ __forceinline__ int lds_byte(int r, int c) { const int st = (r >> 4) * 2 + (c >> 5), rr = r & 15, cc = c & 31, ob = rr * 64 + cc * 2; return st * 1024 + (ob ^ (((ob >> 9) & 1) << 5)); }
__host__ __device__ __forceinline__ void stage_rc(int b, int& R, int& C) { const int st = b / 1024, sb = b % 1024, swz = sb ^ (((sb >> 9) & 1) << 5); R = (st >> 1) * 16 + swz / 64; C = (st & 1) * 32 + (swz % 64) / 2; }
__host__ __device__ __forceinline__ int perm32(int rho) { const int n = rho >> 4, i = rho & 15; return 8 * (i >> 2) + 4 * n + (i & 3); }

struct Unit { int pm, pn; };
struct Gemm { const bf16_t* A; const bf16_t* Bt; int M, N, K, lda, ldb, adiv, aoff; };

struct StaticOrder {
    int nM, nN, nwg, G, c;
    __host__ __device__ void init(int M, int N, int G_, int c_) { nM = M / BM; nN = N / BM; nwg = nM * nN; G = G_; c = c_; }
    __host__ __device__ bool next(int i, Unit& u) const {
        const long L = (long)i * G + c; if (L >= nwg) return false;
        int wgid = (int)L; { const int q = nwg / NXCD, r = nwg % NXCD, xcd = wgid % NXCD, off = wgid / NXCD; wgid = (xcd < r ? xcd * (q + 1) : r * (q + 1) + (xcd - r) * q) + off; }
        const int nig = WGM * nN, gid = wgid / nig, fm = gid * WGM, gsz = (nM - fm) < WGM ? (nM - fm) : WGM;
        u.pm = fm + ((wgid % nig) % gsz); u.pn = (wgid % nig) / gsz; return true;
    }
    __device__ __forceinline__ void a_ready(const Unit&) const {}
    __device__ __forceinline__ void done(const Unit&) const {}
};
typedef float f32x2c __attribute__((ext_vector_type(2)));
typedef __bf16 bf16x2c __attribute__((ext_vector_type(2)));
__device__ __forceinline__ unsigned cvt_pk_bf16(float lo, float hi) { const f32x2c v = {lo, hi}; const bf16x2c r = __builtin_convertvector(v, bf16x2c); return __builtin_bit_cast(unsigned, r); }
template <class Epi, class Sched, bool ALIGN_EPI = false, bool SP2 = false>
__device__ __forceinline__ void gemm_phase(PG8_LAS unsigned char* lds, const Gemm g, const Sched& S, const Epi& E) {
    const int tid = opaque_tid(), wid = __builtin_amdgcn_readfirstlane(tid >> 6), lane = tid & 63, wr = wid >> 2, wc = wid & 3, fr = lane & 15, fq = lane >> 4;
    const int K = g.K, nt = K / BK;
    unsigned voffA[2], voffB[2];
#pragma unroll
    for (int i = 0; i < 2; ++i) { int R, C; stage_rc(tid * 16 + i * 8192, R, C); const int Rb = Epi::PERM ? ((R & ~31) + perm32(R & 31)) : R;
        voffA[i] = (unsigned)(R * g.lda + C) * 2u; voffB[i] = (unsigned)(Rb * g.ldb + C) * 2u; }
    const size_t kstep = (size_t)(BK * 2);
    const size_t hstepA = (size_t)HALF * g.lda * 2, hstepB = (size_t)HALF * g.ldb * 2;
    const size_t tstepA = 2 * hstepA, tstepB = 2 * hstepB;
    const unsigned ldsw = (unsigned)wid * 1024u;
    const int aoff = lds_byte(wr * 64 + fr, fq * 8), boff = lds_byte(wc * 32 + fr, fq * 8);
#define PG8_SA(b, h) (((b) * 2 + (h)) * HTB)
#define PG8_SB(b, h) ((4 + (b) * 2 + (h)) * HTB)
#define PG8_STAGE(bufoff, gbase, voff) do { _Pragma("unroll") for (int _i = 0; _i < 2; ++_i) \
        __builtin_amdgcn_global_load_lds((const unsigned*)((const char*)(gbase) + (voff)[_i]), (PG8_LAS unsigned*)(lds + (bufoff) + ldsw + _i * 8192), 16, 0, 0); } while (0)
#define PG8_LDA(dst, b, h) do { _Pragma("unroll") for (int m = 0; m < 4; ++m) _Pragma("unroll") for (int k = 0; k < 2; ++k) dst[m][k] = *(const PG8_LAS bf16x8*)(lds + PG8_SA(b, h) + aoff + m * 2048 + k * 1024); } while (0)
#define PG8_LDB(dst, b, h) do { _Pragma("unroll") for (int n = 0; n < 2; ++n) _Pragma("unroll") for (int k = 0; k < 2; ++k) dst[n][k] = *(const PG8_LAS bf16x8*)(lds + PG8_SB(b, h) + boff + n * 2048 + k * 1024); } while (0)
#define PG8_MMA(ai, bj, At, Bt) do { __builtin_amdgcn_s_setprio(1); _Pragma("unroll") for (int m = 0; m < 4; ++m) _Pragma("unroll") for (int n = 0; n < 2; ++n) _Pragma("unroll") for (int k = 0; k < 2; ++k) \
        acc[ai][bj][m][n] = __builtin_amdgcn_mfma_f32_16x16x32_bf16(Bt[n][k], At[m][k], acc[ai][bj][m][n], 0, 0, 0); __builtin_amdgcn_s_setprio(0); } while (0)
#define PG8_WAIT_V(n) asm volatile("s_waitcnt vmcnt(" #n ")" ::: "memory")
#define PG8_WAIT_L(n) asm volatile("s_waitcnt lgkmcnt(" #n ")" ::: "memory")
#define PG8_BAR __builtin_amdgcn_s_barrier()
#define PG8_SCHED __builtin_amdgcn_sched_barrier(0)
    Unit cur, nxt; int ui = 0;
    if (!S.next(0, cur)) return;
    f32x4 acc[2][2][4][2];
#pragma unroll
    for (int a = 0; a < 2; ++a)
#pragma unroll
        for (int b = 0; b < 2; ++b)
#pragma unroll
            for (int m = 0; m < 4; ++m)
#pragma unroll
                for (int n = 0; n < 2; ++n) acc[a][b][m][n] = (f32x4){0.f, 0.f, 0.f, 0.f};
    bf16x8 At[4][2], B0[2][2], B1[2][2];
    const char* cA = (const char*)g.A + (size_t)cur.pm * tstepA + (size_t)(cur.pn / g.adiv) * g.aoff * 2; const char* cB = (const char*)g.Bt + (size_t)cur.pn * tstepB;
    S.a_ready(cur);
    if constexpr (SP2) {
        PG8_STAGE(PG8_SB(0, 0), cB, voffB); PG8_STAGE(PG8_SB(0, 1), cB + hstepB, voffB); PG8_STAGE(PG8_SA(0, 0), cA, voffA); PG8_STAGE(PG8_SA(0, 1), cA + hstepA, voffA);
        if (wr == 1) PG8_BAR;
        PG8_WAIT_V(2); PG8_BAR;
        PG8_STAGE(PG8_SB(1, 0), cB + kstep, voffB); PG8_STAGE(PG8_SA(1, 0), cA + kstep, voffA); PG8_STAGE(PG8_SB(1, 1), cB + hstepB + kstep, voffB);
        PG8_WAIT_V(6); PG8_BAR;
    } else {
        PG8_STAGE(PG8_SB(0, 0), cB, voffB); PG8_STAGE(PG8_SA(0, 0), cA, voffA); PG8_STAGE(PG8_SB(0, 1), cB + hstepB, voffB); PG8_STAGE(PG8_SA(0, 1), cA + hstepA, voffA);
        if (wr == 1) PG8_BAR;
        PG8_WAIT_V(4); PG8_BAR;
        PG8_STAGE(PG8_SB(1, 0), cB + kstep, voffB); PG8_STAGE(PG8_SA(1, 0), cA + kstep, voffA); PG8_STAGE(PG8_SB(1, 1), cB + hstepB + kstep, voffB);
        PG8_WAIT_V(6); PG8_BAR;
    }
    for (;;) {
        const bool has_next = S.next(ui + 1, nxt);
        const char* nA = has_next ? (const char*)g.A + (size_t)nxt.pm * tstepA + (size_t)(nxt.pn / g.adiv) * g.aoff * 2 : cA; const char* nB = has_next ? (const char*)g.Bt + (size_t)nxt.pn * tstepB : cB;
        for (int t = 0; t < nt; t += 2) {
            const bool last = (t == nt - 2);
            const char* a1 = cA + (size_t)(t + 1) * kstep;
            const char* a2 = last ? nA : cA + (size_t)(t + 2) * kstep; const char* b2 = last ? nB : cB + (size_t)(t + 2) * kstep;
            const char* a3 = a2 + kstep; const char* b3 = b2 + kstep;
            if (last && has_next) S.a_ready(nxt);
            if constexpr (SP2) {
            PG8_LDB(B0, 0, 0); PG8_LDB(B1, 0, 1); PG8_SCHED; PG8_LDA(At, 0, 0); PG8_STAGE(PG8_SA(1, 1), a1 + hstepA, voffA);
            PG8_WAIT_V(8); PG8_WAIT_L(0); PG8_BAR; PG8_MMA(0, 0, At, B0); PG8_MMA(0, 1, At, B1); PG8_BAR; PG8_SCHED;
            PG8_LDA(At, 0, 1); PG8_STAGE(PG8_SB(0, 0), b2, voffB); PG8_STAGE(PG8_SB(0, 1), b2 + hstepB, voffB); PG8_STAGE(PG8_SA(0, 0), a2, voffA);
            PG8_WAIT_V(8); PG8_WAIT_L(0); PG8_BAR; PG8_MMA(1, 0, At, B0); PG8_MMA(1, 1, At, B1); PG8_BAR; PG8_SCHED;
            PG8_LDB(B0, 1, 0); PG8_LDB(B1, 1, 1); PG8_SCHED; PG8_LDA(At, 1, 0); PG8_STAGE(PG8_SA(0, 1), a2 + hstepA, voffA);
            PG8_WAIT_V(8); PG8_WAIT_L(0); PG8_BAR; PG8_MMA(0, 0, At, B0); PG8_MMA(0, 1, At, B1); PG8_BAR; PG8_SCHED;
            PG8_LDA(At, 1, 1); PG8_STAGE(PG8_SB(1, 0), b3, voffB); PG8_STAGE(PG8_SB(1, 1), b3 + hstepB, voffB); PG8_STAGE(PG8_SA(1, 0), a3, voffA);
            PG8_WAIT_V(8); PG8_WAIT_L(0); PG8_BAR; PG8_MMA(1, 0, At, B0); PG8_MMA(1, 1, At, B1); PG8_BAR; PG8_SCHED;
            } else {
            PG8_LDB(B0, 0, 0); PG8_SCHED; PG8_LDA(At, 0, 0); PG8_STAGE(PG8_SA(1, 1), a1 + hstepA, voffA);
            PG8_WAIT_L(8); PG8_BAR; PG8_WAIT_L(0); PG8_MMA(0, 0, At, B0); PG8_BAR; PG8_SCHED;
            PG8_LDB(B1, 0, 1); PG8_STAGE(PG8_SB(0, 0), b2, voffB);
            PG8_BAR; PG8_WAIT_L(0); PG8_MMA(0, 1, At, B1); PG8_BAR;
            PG8_LDA(At, 0, 1); PG8_STAGE(PG8_SA(0, 0), a2, voffA);
            PG8_BAR; PG8_WAIT_L(0); PG8_MMA(1, 0, At, B0); PG8_BAR; PG8_SCHED;
            PG8_STAGE(PG8_SB(0, 1), b2 + hstepB, voffB);
            PG8_WAIT_V(6); PG8_BAR; PG8_MMA(1, 1, At, B1); PG8_BAR;
            PG8_LDB(B0, 1, 0); PG8_SCHED; PG8_LDA(At, 1, 0); PG8_STAGE(PG8_SA(0, 1), a2 + hstepA, voffA);
            PG8_WAIT_L(8); PG8_BAR; PG8_WAIT_L(0); PG8_MMA(0, 0, At, B0); PG8_BAR; PG8_SCHED;
            PG8_LDB(B1, 1, 1); PG8_STAGE(PG8_SB(1, 0), b3, voffB);
            PG8_BAR; PG8_WAIT_L(0); PG8_MMA(0, 1, At, B1); PG8_BAR;
            PG8_LDA(At, 1, 1); PG8_STAGE(PG8_SA(1, 0), a3, voffA);
            PG8_BAR; PG8_WAIT_L(0); PG8_MMA(1, 0, At, B0); PG8_BAR; PG8_SCHED;
            PG8_STAGE(PG8_SB(1, 1), b3 + hstepB, voffB);
            PG8_WAIT_V(6); PG8_BAR; PG8_MMA(1, 1, At, B1); PG8_BAR;
            }
        }
        if constexpr (ALIGN_EPI) { if (wr == 0) PG8_BAR; }
        if constexpr (!Epi::AFTER_DRAIN) { E(acc, cur, wr, wc, fr, fq); S.done(cur); }
        if (!has_next) break;
#pragma unroll
        for (int a = 0; a < 2; ++a)
#pragma unroll
            for (int b = 0; b < 2; ++b)
#pragma unroll
                for (int m = 0; m < 4; ++m)
#pragma unroll
                    for (int n = 0; n < 2; ++n) acc[a][b][m][n] = (f32x4){0.f, 0.f, 0.f, 0.f};
        cur = nxt; cA = nA; cB = nB; ++ui;
        if constexpr (ALIGN_EPI) { if (wr == 1) PG8_BAR; }
    }
    PG8_WAIT_V(0);
    if constexpr (!ALIGN_EPI) { if (wr == 0) PG8_BAR; }
    PG8_BAR;
    if constexpr (Epi::AFTER_DRAIN) { E.fused(acc, cur, wr, wc, fr, fq, lds, wid, lane); S.done(cur); }
#undef PG8_SA
#undef PG8_SB
#undef PG8_STAGE
#undef PG8_LDA
#undef PG8_LDB
#undef PG8_MMA
#undef PG8_WAIT_V
#undef PG8_WAIT_L
#undef PG8_BAR
#undef PG8_SCHED
}
}

using pg8::bf16_t; using pg8::bf16x8; using pg8::f32x4; using pg8::cvt_pk_bf16;
#define LAS __attribute__((address_space(3)))
typedef unsigned u32x2 __attribute__((ext_vector_type(2)));
typedef unsigned u32x4v __attribute__((ext_vector_type(4)));
typedef unsigned long long u64;

constexpr int DM = 1024, NB = 8, SQ = 4096, NTOK = NB * SQ, DFF = 2816, INC = 3864;
constexpr int NTHR = 512;
constexpr int LDS_BYTES = 147456;

enum { I_X = 0, I_C, I_MODW, I_MODB, I_NORMG, I_W13, I_W2, I_WIN, I_LNG, I_LNB, I_GWS, I_GBS, I_PE, I_CW1, I_CW2, I_CONVW, I_WBR, I_WGATE, I_WOUT, N_IN };

constexpr size_t SZ_W13 = (size_t)5632 * 1024 * 2, SZ_W2 = (size_t)1024 * 2816 * 2;
constexpr size_t WS_W13 = 0;
constexpr size_t WS_W2 = WS_W13 + 2 * SZ_W13;
constexpr size_t WS_WIN = WS_W2 + 2 * SZ_W2;
constexpr size_t WS_WG = WS_WIN + (size_t)4096 * 1024 * 2;
constexpr size_t WS_WB = WS_WG + (size_t)3072 * 1024 * 2;
constexpr size_t WS_WO3 = WS_WB + (size_t)3072 * 512 * 2;
constexpr size_t WS_WC1 = WS_WO3 + (size_t)1024 * 3072 * 2;
constexpr size_t WS_H = WS_WC1 + (size_t)2 * 256 * 2048 * 2;
constexpr size_t WS_R1 = WS_H + (size_t)NTOK * DM * 2;
constexpr size_t SZ_R1 = (size_t)253 * 1024 * 1024 - 0;
constexpr size_t WS_R2 = WS_R1 + (size_t)241 * 1024 * 1024;
constexpr size_t WS_NG = WS_R2 + (size_t)NTOK * 1536 * 2;
constexpr size_t WS_HID = WS_NG + (size_t)NTOK * 24 * 4;
constexpr size_t WS_KC = WS_HID + (size_t)2 * 4096 * 128 * 2;
constexpr size_t WS_MOD = WS_KC + (size_t)2 * 16 * 256 * 64 * 2;
constexpr size_t WS_ROPE = WS_MOD + (size_t)2 * 8 * 9216 * 4;
constexpr size_t WS_CB1 = WS_ROPE + (size_t)4096 * 16 * 4;
constexpr size_t WS_BAR = WS_CB1 + 4096;
constexpr size_t WS_UL = WS_BAR + 16384;
constexpr size_t WS_END = WS_UL + (size_t)4 * 4096 * 256 * 4;
constexpr size_t R1_ACT = 0, R1_Y1 = (size_t)NTOK * DFF * 2;
constexpr size_t R1_AIN = 0, R1_Q = (size_t)NTOK * 1024 * 2, R1_KV = R1_Q + (size_t)NTOK * 512 * 2, R1_C = R1_KV + (size_t)6 * 16 * 4096 * 64 * 2 + 4096;
constexpr size_t R1_GATES = 0;
static_assert(R1_C + (size_t)NTOK * 1536 * 2 <= (size_t)241 * 1024 * 1024, "R1");
static_assert(R1_Y1 + (size_t)NTOK * DM * 2 <= (size_t)241 * 1024 * 1024, "R1b");
constexpr size_t KVSZ = (size_t)16 * 4096 * 64;

struct Args { const float* in[N_IN]; float* out; unsigned char* ws; };

__device__ __forceinline__ float bf2f(unsigned short v) { return __uint_as_float((unsigned)v << 16); }
__device__ __forceinline__ unsigned short f2bf(float f) { return (unsigned short)(cvt_pk_bf16(f, 0.f) & 0xffffu); }
__device__ __forceinline__ float gelu_t(float x) { const float u = 0.7978845608f * (x + 0.044715f * x * x * x); return x * __builtin_amdgcn_rcpf(1.f + __builtin_amdgcn_exp2f(-2.885390082f * u)); }
__device__ __forceinline__ float sigm(float x) { return __builtin_amdgcn_rcpf(1.f + __builtin_amdgcn_exp2f(-1.4426950408889634f * x)); }
__device__ __forceinline__ float wave_sum(float v) {
#pragma unroll
    for (int o = 32; o >= 1; o >>= 1) v += __shfl_xor(v, o);
    return v;
}

struct CmId { __device__ int operator()(int n) const { return n; } };
struct CmW13 { __device__ int operator()(int n) const { const int t = n >> 8, r = n & 255; return r < 128 ? t * 128 + r : DFF + t * 128 + (r - 128); } };
struct CmWin { __device__ int operator()(int n) const { return n < 2304 ? n : (n < 3840 ? n + 24 : (n < 3864 ? n - 3840 + 2304 : -1)); } };
struct CmC1 { __device__ int operator()(int n) const { return n < 128 ? n : -1; } };

struct TJob { const float* src; bf16_t* dst; int ld_src, ld_dst, ntk, cm; };
__device__ __forceinline__ int tj_col(int cm, int n) {
    if (cm == 1) { const int t = n >> 8, r = n & 255; return r < 128 ? t * 128 + r : DFF + t * 128 + (r - 128); }
    if (cm == 2) return n < 2304 ? n : (n < 3840 ? n + 24 : (n < 3864 ? n - 3840 + 2304 : -1));
    return n;
}
__device__ __forceinline__ void transpose_tile(const TJob& jb, int t, LAS float* tl, int otid) {
    const int j = otid & 63, i = otid >> 6;
    const int tn = t / jb.ntk, tk = t - tn * jb.ntk, n0 = tn * 64, k0 = tk * 128;
    const int sc = tj_col(jb.cm, n0 + j);
    float v[16];
#pragma unroll
    for (int kk = 0; kk < 16; ++kk) v[kk] = sc >= 0 ? jb.src[(size_t)(k0 + i + kk * 8) * jb.ld_src + sc] : 0.f;
#pragma unroll
    for (int kk = 0; kk < 16; ++kk) tl[(i + kk * 8) * 65 + j] = v[kk];
    __syncthreads();
    const int r = otid >> 3, c8 = (otid & 7) * 8;
#pragma unroll
    for (int hh = 0; hh < 2; ++hh) {
        const int cb = hh * 64 + c8;
        u32x4v w;
        w.x = cvt_pk_bf16(tl[(cb + 0) * 65 + r], tl[(cb + 1) * 65 + r]); w.y = cvt_pk_bf16(tl[(cb + 2) * 65 + r], tl[(cb + 3) * 65 + r]);
        w.z = cvt_pk_bf16(tl[(cb + 4) * 65 + r], tl[(cb + 5) * 65 + r]); w.w = cvt_pk_bf16(tl[(cb + 6) * 65 + r], tl[(cb + 7) * 65 + r]);
        *(u32x4v*)(jb.dst + (size_t)(n0 + r) * jb.ld_dst + k0 + cb) = w;
    }
    __syncthreads();
}

#define TJ_JOB(SRC, LDSRC, KK, NP, CM, DST, LDDST) { const int nt_ = ((KK) / 128) * ((NP) / 64); if (!found) { if (tt < nt_) { found = true; jb.src = (SRC); jb.dst = (DST); jb.ld_src = (LDSRC); jb.ld_dst = (LDDST); jb.ntk = (KK) / 128; jb.cm = (CM); } else tt -= nt_; } }
__device__ __forceinline__ void convert_weights(const Args& a, int l, LAS unsigned char* lds) {
    const int otid = opaque_tid();
    LAS float* tl = (LAS float*)lds;
    unsigned char* ws = a.ws;
    constexpr int TOTAL = 2 * (8 * 88) + 2 * (22 * 16) + 8 * 64 + 8 * 48 + 3 * (4 * 16) + 8 * 16 + 4 * (8 * 2);
    for (int t = blockIdx.x; t < TOTAL; t += gridDim.x) {
        int tt = t; bool found = false; TJob jb; jb.src = nullptr; jb.dst = nullptr; jb.ld_src = 0; jb.ld_dst = 0; jb.ntk = 1; jb.cm = 0;
        TJ_JOB(a.in[I_W13] + (size_t)(l * 2 + 0) * 1024 * 5632, 5632, 1024, 5632, 1, (bf16_t*)(ws + WS_W13), 1024)
        TJ_JOB(a.in[I_W13] + (size_t)(l * 2 + 1) * 1024 * 5632, 5632, 1024, 5632, 1, (bf16_t*)(ws + WS_W13 + SZ_W13), 1024)
        TJ_JOB(a.in[I_W2] + (size_t)(l * 2 + 0) * 2816 * 1024, 1024, 2816, 1024, 0, (bf16_t*)(ws + WS_W2), 2816)
        TJ_JOB(a.in[I_W2] + (size_t)(l * 2 + 1) * 2816 * 1024, 1024, 2816, 1024, 0, (bf16_t*)(ws + WS_W2 + SZ_W2), 2816)
        TJ_JOB(a.in[I_WIN] + (size_t)l * 1024 * INC, INC, 1024, 4096, 2, (bf16_t*)(ws + WS_WIN), 1024)
        TJ_JOB(a.in[I_WGATE] + (size_t)l * 1024 * 3072, 3072, 1024, 3072, 0, (bf16_t*)(ws + WS_WG), 1024)
        TJ_JOB(a.in[I_WBR] + (size_t)(l * 3 + 0) * 512 * 1024, 1024, 512, 1024, 0, (bf16_t*)(ws + WS_WB) + (size_t)0 * 1024 * 512, 512)
        TJ_JOB(a.in[I_WBR] + (size_t)(l * 3 + 1) * 512 * 1024, 1024, 512, 1024, 0, (bf16_t*)(ws + WS_WB) + (size_t)1 * 1024 * 512, 512)
        TJ_JOB(a.in[I_WBR] + (size_t)(l * 3 + 2) * 512 * 1024, 1024, 512, 1024, 0, (bf16_t*)(ws + WS_WB) + (size_t)2 * 1024 * 512, 512)
        TJ_JOB(a.in[I_WOUT] + (size_t)l * 1024 * 1024, 1024, 1024, 1024, 0, (bf16_t*)(ws + WS_WO3), 1024)
        TJ_JOB(a.in[I_CW1] + (size_t)(l * 2 + 0) * 2048 * 128, 128, 1024, 128, 0, (bf16_t*)(ws + WS_WC1), 1024)
        TJ_JOB(a.in[I_CW1] + (size_t)(l * 2 + 0) * 2048 * 128 + (size_t)1024 * 128, 128, 1024, 128, 0, (bf16_t*)(ws + WS_WC1) + (size_t)128 * 1024, 1024)
        TJ_JOB(a.in[I_CW1] + (size_t)(l * 2 + 1) * 2048 * 128, 128, 1024, 128, 0, (bf16_t*)(ws + WS_WC1) + (size_t)256 * 1024, 1024)
        TJ_JOB(a.in[I_CW1] + (size_t)(l * 2 + 1) * 2048 * 128 + (size_t)1024 * 128, 128, 1024, 128, 0, (bf16_t*)(ws + WS_WC1) + (size_t)256 * 1024 + (size_t)128 * 1024, 1024)
        transpose_tile(jb, tt, tl, otid);
    }
    const int kvb = (int)blockIdx.x - ((int)gridDim.x - 32);
    if (kvb >= 0) {
        const int kv = kvb >> 4, h0 = (kvb & 15) * 8, hh = otid & 7, ks = otid >> 3;
        const float* pe = a.in[I_PE] + (size_t)(l * 2 + kv) * 2048 + ks * 32; const float* w1 = a.in[I_CW1] + (size_t)(l * 2 + kv) * 2048 * 128 + (size_t)ks * 32 * 128 + h0 + hh;
        float s = 0.f;
#pragma unroll 8
        for (int k = 0; k < 32; ++k) s += pe[k] * w1[(size_t)k * 128];
        __syncthreads();
        tl[otid] = s;
        __syncthreads();
        if (otid < 8) { float t = 0.f; for (int q = 0; q < 64; ++q) t += tl[q * 8 + otid]; ((float*)(ws + WS_CB1))[kv * 128 + h0 + otid] = t; }
        __syncthreads();
    }
}

__device__ __forceinline__ void mod_rope_phase(const Args& a, LAS unsigned char* lds) {
    const int otid = opaque_tid();
    LAS float* sc = (LAS float*)lds;
    LAS float* red = (LAS float*)(lds + 32768);
    const int tid = otid, lane = tid & 63, w = tid >> 6;
    for (int i = tid; i < 8192; i += NTHR) { const float v = a.in[I_C][i]; sc[i] = v / (1.f + __expf(-v)); }
    __syncthreads();
    float* MOD = (float*)(a.ws + WS_MOD);
    for (int u = blockIdx.x; u < 288; u += gridDim.x) {
        const int l = u / 144, j0 = (u % 144) * 64;
        const float* mw = a.in[I_MODW] + (size_t)l * 1024 * 9216 + j0 + lane;
        float acc[8];
#pragma unroll
        for (int b = 0; b < 8; ++b) acc[b] = 0.f;
        for (int k = w * 128; k < w * 128 + 128; k += 16) {
            float wv[16];
#pragma unroll
            for (int q = 0; q < 16; ++q) wv[q] = mw[(size_t)(k + q) * 9216];
#pragma unroll
            for (int q = 0; q < 16; ++q)
#pragma unroll
                for (int b = 0; b < 8; ++b) acc[b] += sc[b * 1024 + k + q] * wv[q];
        }
#pragma unroll
        for (int b = 0; b < 8; ++b) red[(w * 8 + b) * 64 + lane] = acc[b];
        __syncthreads();
        {
            const int b = w; float s = 0.f;
#pragma unroll
            for (int sl = 0; sl < 8; ++sl) s += red[(sl * 8 + b) * 64 + lane];
            MOD[(size_t)(l * 8 + b) * 9216 + j0 + lane] = s + a.in[I_MODB][l * 9216 + j0 + lane];
        }
        __syncthreads();
    }
    float* RT = (float*)(a.ws + WS_ROPE);
    for (int i = blockIdx.x * NTHR + tid; i < 4096 * 8; i += gridDim.x * NTHR) {
        const int s = i >> 3, e = i & 7;
        const float inv = 1.0f / powf(500000.0f, (float)(2 * e) / 16.0f);
        const float ang = (float)s * inv;
        RT[i * 2] = cosf(ang); RT[i * 2 + 1] = sinf(ang);
    }
}

__device__ __forceinline__ u32x2 pack4(f32x4 v) { u32x2 o; o.x = cvt_pk_bf16(v[0], v[1]); o.y = cvt_pk_bf16(v[2], v[3]); return o; }
struct NormRows { f32x4 xv[2][4]; u32x2 yr[2][4]; };
__device__ __forceinline__ void norm_load(NormRows& R, const void* xin, bool xin_bf, const bf16_t* y, int r, int lane) {
#pragma unroll
    for (int q = 0; q < 2; ++q)
#pragma unroll
        for (int s = 0; s < 4; ++s) {
            const size_t e = (size_t)(r + q) * DM + s * 256 + lane * 4;
            if (xin_bf) { const u32x2 t = __builtin_nontemporal_load((const u32x2*)((const bf16_t*)xin + e));
                R.xv[q][s] = (f32x4){__uint_as_float(t.x << 16), __uint_as_float(t.x & 0xffff0000u), __uint_as_float(t.y << 16), __uint_as_float(t.y & 0xffff0000u)}; }
            else R.xv[q][s] = __builtin_nontemporal_load((const f32x4*)((const float*)xin + e));
            if (y) R.yr[q][s] = __builtin_nontemporal_load((const u32x2*)(y + e));
        }
}
__device__ __forceinline__ void norm_rows(NormRows& R, bool hasy, const f32x4 (&gp)[4], const f32x4 (&pa)[4], const float* mshift, int b, void* xout, bool xout_bf, bf16_t* h, int r, int lane) {
    if (hasy) {
        float ss[2];
#pragma unroll
        for (int q = 0; q < 2; ++q) { float t = 0.f;
#pragma unroll
            for (int s = 0; s < 4; ++s) { const float a0 = __uint_as_float(R.yr[q][s].x << 16), a1 = __uint_as_float(R.yr[q][s].x & 0xffff0000u), a2 = __uint_as_float(R.yr[q][s].y << 16), a3 = __uint_as_float(R.yr[q][s].y & 0xffff0000u);
                t += a0 * a0 + a1 * a1 + a2 * a2 + a3 * a3; }
            ss[q] = t; }
#pragma unroll
        for (int o = 32; o >= 1; o >>= 1)
#pragma unroll
            for (int q = 0; q < 2; ++q) ss[q] += __shfl_xor(ss[q], o);
#pragma unroll
        for (int q = 0; q < 2; ++q) { const float rs = rsqrtf(ss[q] * (1.f / DM) + 1e-6f);
#pragma unroll
            for (int s = 0; s < 4; ++s) { const f32x4 yv = (f32x4){__uint_as_float(R.yr[q][s].x << 16), __uint_as_float(R.yr[q][s].x & 0xffff0000u), __uint_as_float(R.yr[q][s].y << 16), __uint_as_float(R.yr[q][s].y & 0xffff0000u)};
                R.xv[q][s] += gp[s] * (yv * rs);
                const size_t e = (size_t)(r + q) * DM + s * 256 + lane * 4;
                if (xout_bf) { const u32x2 pk = pack4(R.xv[q][s]); *(u32x2*)((bf16_t*)xout + e) = pk;
                    R.xv[q][s] = (f32x4){__uint_as_float(pk.x << 16), __uint_as_float(pk.x & 0xffff0000u), __uint_as_float(pk.y << 16), __uint_as_float(pk.y & 0xffff0000u)}; }
                else *(f32x4*)((float*)xout + e) = R.xv[q][s]; } }
    }
    if (h) {
        float ss[2]; f32x4 ps[4];
#pragma unroll
        for (int s = 0; s < 4; ++s) ps[s] = *(const f32x4*)(mshift + b * 9216 + s * 256 + lane * 4);
#pragma unroll
        for (int q = 0; q < 2; ++q) { float t = 0.f;
#pragma unroll
            for (int s = 0; s < 4; ++s) { const f32x4 v = R.xv[q][s]; t += v[0] * v[0] + v[1] * v[1] + v[2] * v[2] + v[3] * v[3]; }
            ss[q] = t; }
#pragma unroll
        for (int o = 32; o >= 1; o >>= 1)
#pragma unroll
            for (int q = 0; q < 2; ++q) ss[q] += __shfl_xor(ss[q], o);
#pragma unroll
        for (int q = 0; q < 2; ++q) { const float rs = rsqrtf(ss[q] * (1.f / DM) + 1e-6f);
#pragma unroll
            for (int s = 0; s < 4; ++s) { const f32x4 o = R.xv[q][s] * rs * pa[s] + ps[s];
                *(u32x2*)(h + (size_t)(r + q) * DM + s * 256 + lane * 4) = pack4(o); } }
    }
}
__device__ __forceinline__ void norm_phase(const void* xin, bool xin_bf, const bf16_t* y, const float* gpost, const float* mgate, float rw,
                                           const float* gpre, const float* mshift, const float* mscale, void* xout, bool xout_bf, bf16_t* h) {
    const int otid = opaque_tid();
    const int lane = otid & 63, w = otid >> 6;
    const int nw = gridDim.x * 8, rows_per = NTOK / nw;
    const int gw = blockIdx.x * 8 + w;
    const int r0 = gw * rows_per, b = r0 / SQ;
    f32x4 gp[4], pa[4];
#pragma unroll
    for (int s = 0; s < 4; ++s) {
        const int c = s * 256 + lane * 4;
        if (y) { const f32x4 g1 = *(const f32x4*)(mgate + b * 9216 + c), g2 = *(const f32x4*)(gpost + c); gp[s] = g1 * g2 * rw; } else gp[s] = (f32x4){0.f, 0.f, 0.f, 0.f};
        if (h) { const f32x4 g1 = *(const f32x4*)(gpre + c), g2 = *(const f32x4*)(mscale + b * 9216 + c); pa[s] = g1 * (g2 + 1.f); }
        else { pa[s] = (f32x4){0.f, 0.f, 0.f, 0.f}; }
    }
    NormRows A, B;
    norm_load(A, xin, xin_bf, y, r0, lane);
    for (int r = r0; r < r0 + rows_per; r += 4) {
        norm_load(B, xin, xin_bf, y, r + 2, lane);
        norm_rows(A, y != nullptr, gp, pa, mshift, b, xout, xout_bf, h, r, lane);
        if (r + 4 < r0 + rows_per) norm_load(A, xin, xin_bf, y, r + 4, lane);
        norm_rows(B, y != nullptr, gp, pa, mshift, b, xout, xout_bf, h, r + 2, lane);
    }
}

#define EPI8(...) \
    _Pragma("unroll") for (int ai = 0; ai < 2; ++ai) _Pragma("unroll") for (int m = 0; m < 4; ++m) { const int row = u.pm * 256 + ai * 128 + wr * 64 + m * 16 + fr; \
    _Pragma("unroll") for (int bj = 0; bj < 2; ++bj) { const int c8 = bj * 128 + wc * 32 + fq * 8; const f32x4 v0 = acc[ai][bj][m][0], v1 = acc[ai][bj][m][1]; __VA_ARGS__ } }
__device__ __forceinline__ u32x4v pack8(f32x4 a, f32x4 b) { u32x4v o; o.x = cvt_pk_bf16(a[0], a[1]); o.y = cvt_pk_bf16(a[2], a[3]); o.z = cvt_pk_bf16(b[0], b[1]); o.w = cvt_pk_bf16(b[2], b[3]); return o; }
__device__ __forceinline__ f32x4 unlo(u32x4v g) { return (f32x4){__uint_as_float(g.x << 16), __uint_as_float(g.x & 0xffff0000u), __uint_as_float(g.y << 16), __uint_as_float(g.y & 0xffff0000u)}; }
__device__ __forceinline__ f32x4 unhi(u32x4v g) { return (f32x4){__uint_as_float(g.z << 16), __uint_as_float(g.z & 0xffff0000u), __uint_as_float(g.w << 16), __uint_as_float(g.w & 0xffff0000u)}; }
__device__ __forceinline__ f32x4 sig4(f32x4 v) { return (f32x4){sigm(v[0]), sigm(v[1]), sigm(v[2]), sigm(v[3])}; }
__device__ __forceinline__ f32x4 gelu4(f32x4 v) { return (f32x4){gelu_t(v[0]), gelu_t(v[1]), gelu_t(v[2]), gelu_t(v[3])}; }

struct EpiPlain {
    static constexpr bool PERM = true, AFTER_DRAIN = false;
    bf16_t* O; int ldc;
    __device__ __forceinline__ void operator()(const f32x4 (&acc)[2][2][4][2], const pg8::Unit& u, int wr, int wc, int fr, int fq) const {
        EPI8( *(u32x4v*)(O + (size_t)row * ldc + u.pn * 256 + c8) = pack8(v0, v1); )
    }
};
struct EpiSigmoid {
    static constexpr bool PERM = true, AFTER_DRAIN = false;
    bf16_t* O; int ldc;
    __device__ __forceinline__ void operator()(const f32x4 (&acc)[2][2][4][2], const pg8::Unit& u, int wr, int wc, int fr, int fq) const {
        EPI8( *(u32x4v*)(O + (size_t)row * ldc + u.pn * 256 + c8) = pack8(sig4(v0), sig4(v1)); )
    }
};
struct EpiBranchAcc {
    static constexpr bool PERM = true, AFTER_DRAIN = false;
    const bf16_t* G; bf16_t* Mg;
    __device__ __forceinline__ void operator()(const f32x4 (&acc)[2][2][4][2], const pg8::Unit& u, int wr, int wc, int fr, int fq) const {
        const int nb = u.pn >> 2, dt = u.pn & 3;
#pragma unroll
        for (int ai = 0; ai < 2; ++ai) {
            u32x4v gv[4][2], qv[4][2];
#pragma unroll
            for (int m = 0; m < 4; ++m)
#pragma unroll
                for (int bj = 0; bj < 2; ++bj) {
                    const int row = u.pm * 256 + ai * 128 + wr * 64 + m * 16 + fr, c8 = bj * 128 + wc * 32 + fq * 8;
                    gv[m][bj] = *(const u32x4v*)(G + (size_t)row * 3072 + nb * 1024 + dt * 256 + c8);
                    if (nb > 0) qv[m][bj] = *(const u32x4v*)(Mg + (size_t)row * 1024 + dt * 256 + c8); else qv[m][bj] = (u32x4v){0u, 0u, 0u, 0u};
                }
#pragma unroll
            for (int m = 0; m < 4; ++m)
#pragma unroll
                for (int bj = 0; bj < 2; ++bj) {
                    const int row = u.pm * 256 + ai * 128 + wr * 64 + m * 16 + fr, c8 = bj * 128 + wc * 32 + fq * 8;
                    f32x4 o0 = acc[ai][bj][m][0] * unlo(gv[m][bj]), o1 = acc[ai][bj][m][1] * unhi(gv[m][bj]);
                    if (nb > 0) { o0 += unlo(qv[m][bj]); o1 += unhi(qv[m][bj]); }
                    *(u32x4v*)(Mg + (size_t)row * 1024 + dt * 256 + c8) = pack8(o0, o1);
                }
        }
    }
};
struct BranchOrder {
    pg8::StaticOrder S4;
    __device__ void init(int M, int G_, int c_) { S4.init(M, 1024, G_, c_); }
    __device__ bool next(int i, pg8::Unit& u) const { const int j = i / 3, n = i - 3 * j; pg8::Unit t; if (!S4.next(j, t)) return false; u.pm = t.pm; u.pn = n * 4 + t.pn; return true; }
    __device__ __forceinline__ void a_ready(const pg8::Unit&) const {}
    __device__ __forceinline__ void done(const pg8::Unit&) const {}
};
struct EpiSwiglu {
    static constexpr bool PERM = true, AFTER_DRAIN = false;
    bf16_t* O;
    __device__ __forceinline__ void operator()(const f32x4 (&acc)[2][2][4][2], const pg8::Unit& u, int wr, int wc, int fr, int fq) const {
#pragma unroll
        for (int ai = 0; ai < 2; ++ai)
#pragma unroll
            for (int m = 0; m < 4; ++m) { const int row = u.pm * 256 + ai * 128 + wr * 64 + m * 16 + fr;
                f32x4 o[2];
#pragma unroll
                for (int n = 0; n < 2; ++n) { const f32x4 g = acc[ai][0][m][n], uu = acc[ai][1][m][n];
#pragma unroll
                    for (int j = 0; j < 4; ++j) o[n][j] = g[j] * sigm(g[j]) * uu[j]; }
                *(u32x4v*)(O + (size_t)row * DFF + u.pn * 128 + wc * 32 + fq * 8) = pack8(o[0], o[1]); }
    }
};
struct EpiWin {
    static constexpr bool PERM = true, AFTER_DRAIN = false;
    bf16_t* AIN; bf16_t* Q; bf16_t* KV; bf16_t* C; float* NG;
    __device__ __forceinline__ void operator()(const f32x4 (&acc)[2][2][4][2], const pg8::Unit& u, int wr, int wc, int fr, int fq) const {
        const int pn = u.pn;
        if (pn < 4) { EPI8( *(u32x4v*)(AIN + (size_t)row * 1024 + pn * 256 + c8) = pack8(gelu4(v0), gelu4(v1)); ) }
        else if (pn < 6) { EPI8( *(u32x4v*)(Q + (size_t)row * 512 + (pn - 4) * 256 + c8) = pack8(v0, v1); ) }
        else if (pn < 9) { EPI8( const int cc = (pn - 6) * 256 + c8; const int which = cc >> 7, g = (cc >> 6) & 1, d = cc & 63; const int b = row >> 12, s = row & 4095;
                                 *(u32x4v*)(KV + (size_t)which * KVSZ + ((size_t)(b * 2 + g) * 4096 + s) * 64 + d) = pack8(v0, v1); ) }
        else if (pn < 15) { EPI8( *(u32x4v*)(C + (size_t)row * 1536 + (pn - 9) * 256 + c8) = pack8(v0, v1); ) }
        else { EPI8( if (c8 < 24) { *(f32x4*)(NG + (size_t)row * 24 + c8) = v0; *(f32x4*)(NG + (size_t)row * 24 + c8 + 4) = v1; } ) }
    }
};
struct EpiUL {
    static constexpr bool PERM = true, AFTER_DRAIN = false;
    float* O;
    __device__ __forceinline__ void operator()(const f32x4 (&acc)[2][2][4][2], const pg8::Unit& u, int wr, int wc, int fr, int fq) const {
        EPI8( *(f32x4*)(O + (size_t)row * 256 + c8) = v0; *(f32x4*)(O + (size_t)row * 256 + c8 + 4) = v1; )
    }
};
struct EpiCmp1 {
    static constexpr bool PERM = true, AFTER_DRAIN = false;
    bf16_t* O; const float* cb;
    __device__ __forceinline__ void operator()(const f32x4 (&acc)[2][2][4][2], const pg8::Unit& u, int wr, int wc, int fr, int fq) const {
        EPI8( if (bj == 0) { const f32x4 b0 = *(const f32x4*)(cb + c8), b1 = *(const f32x4*)(cb + c8 + 4);
              *(u32x4v*)(O + (size_t)row * 128 + c8) = pack8(gelu4(v0 + b0), gelu4(v1 + b1)); } )
    }
};

template <class Epi> __device__ __forceinline__ void run_gemm(LAS unsigned char* lds, const bf16_t* A, int lda, const bf16_t* Bt, int ldb, int M, int N, int K, int adiv, int aoff, const Epi& E, int cshift = 0) {
    pg8::Gemm g; g.A = A; g.Bt = Bt; g.M = M; g.N = N; g.K = K; g.lda = lda; g.ldb = ldb; g.adiv = adiv; g.aoff = aoff;
    pg8::StaticOrder S; S.init(M, N, (int)gridDim.x, (int)((blockIdx.x + cshift) % gridDim.x));
    pg8::gemm_phase<Epi, pg8::StaticOrder, true, true>((PG8_LAS unsigned char*)lds, g, S, E);
    __syncthreads();
}

__device__ __forceinline__ void gmlp_phase(const Args& a, int l, LAS unsigned char* lds) {
    const int otid = opaque_tid();
    const bf16_t* AIN = (const bf16_t*)(a.ws + WS_R1 + R1_AIN);
    bf16_t* YS = (bf16_t*)(a.ws + WS_R2);
    LAS bf16_t* Vt = (LAS bf16_t*)lds;
    const int tid = otid, lane = tid & 63, w = tid >> 6, fr = lane & 15, fq = lane >> 4;
    const float* lng = a.in[I_LNG] + l * 512; const float* lnb = a.in[I_LNB] + l * 512;
    const int bx = (int)blockIdx.x; const bool g256 = gridDim.x == 256;
    const bool cmpblk = g256 && ((bx >= 64 && bx < 80) || (bx >= 192 && bx < 208));
    const int extra = !g256 ? -1 : (bx < 16 ? 64 + bx : ((bx >= 128 && bx < 144) ? 192 + (bx - 128) : -1));
    const int nit = (256 - bx + (int)gridDim.x - 1) / (int)gridDim.x;
    for (int ii = 0; ii < nit; ++ii) {
        const int it = bx + ii * (int)gridDim.x;
        const int row0 = it * 128;
        __syncthreads();
        for (int s8 = w * 16; s8 < w * 16 + 16; s8 += 8) {
            float x[8][8]; float sm[8], sq[8];
#pragma unroll
            for (int q = 0; q < 8; ++q) { const bf16_t* vp = AIN + (size_t)(row0 + s8 + q) * 1024 + 512;
#pragma unroll
                for (int e = 0; e < 8; ++e) x[q][e] = bf2f(vp[lane + 64 * e]); }
#pragma unroll
            for (int q = 0; q < 8; ++q) { float t = 0.f;
#pragma unroll
                for (int e = 0; e < 8; ++e) t += x[q][e];
                sm[q] = t; }
#pragma unroll
            for (int o = 32; o >= 1; o >>= 1)
#pragma unroll
                for (int q = 0; q < 8; ++q) sm[q] += __shfl_xor(sm[q], o);
#pragma unroll
            for (int q = 0; q < 8; ++q) { const float mu = sm[q] * (1.f / 512.f); sm[q] = mu; float t = 0.f;
#pragma unroll
                for (int e = 0; e < 8; ++e) { const float d = x[q][e] - mu; t += d * d; }
                sq[q] = t; }
#pragma unroll
            for (int o = 32; o >= 1; o >>= 1)
#pragma unroll
                for (int q = 0; q < 8; ++q) sq[q] += __shfl_xor(sq[q], o);
#pragma unroll
            for (int e = 0; e < 8; ++e) { const int c = lane + 64 * e; const float lg = lng[c], lb = lnb[c];
#pragma unroll
                for (int q = 0; q < 8; ++q) { const float rstd = rsqrtf(sq[q] * (1.f / 512.f) + 1e-6f); Vt[c * 136 + s8 + q] = f2bf((x[q][e] - sm[q]) * rstd * lg + lb); } }
        }
        __syncthreads();
        const int g = w >> 1, jw = w & 1;
        const float* W = a.in[I_GWS] + (size_t)(l * 4 + g) * 128 * 128;
        for (int tix = 0; tix < 4; ++tix) {
            const int T = jw == 0 ? (tix == 0 ? 0 : (tix == 1 ? 7 : (tix == 2 ? 2 : 5))) : (tix == 0 ? 1 : (tix == 1 ? 6 : (tix == 2 ? 3 : 4)));
            const int t0 = T * 16, t = t0 + fr, nkk = (T >> 1) + 1;
            const size_t row = (size_t)(row0 + t);
            f32x4 wl[4][2]; u32x2 uv[8];
#pragma unroll
            for (int kk = 0; kk < 4; ++kk) { if (kk < nkk) { wl[kk][0] = *(const f32x4*)(W + t * 128 + kk * 32 + fq * 8); wl[kk][1] = *(const f32x4*)(W + t * 128 + kk * 32 + fq * 8 + 4); }
                else { wl[kk][0] = (f32x4){0.f, 0.f, 0.f, 0.f}; wl[kk][1] = wl[kk][0]; } }
#pragma unroll
            for (int c = 0; c < 8; ++c) uv[c] = *(const u32x2*)(AIN + row * 1024 + g * 128 + c * 16 + fq * 4);
            const float bias = a.in[I_GBS][(l * 4 + g) * 128 + t];
            f32x4 acc[8];
#pragma unroll
            for (int c = 0; c < 8; ++c) acc[c] = (f32x4){0.f, 0.f, 0.f, 0.f};
#pragma unroll
            for (int kk = 0; kk < 4; ++kk) {
                if (kk < nkk) {
                    const int s0 = kk * 32 + fq * 8;
                    float wv[8] = {wl[kk][0][0], wl[kk][0][1], wl[kk][0][2], wl[kk][0][3], wl[kk][1][0], wl[kk][1][1], wl[kk][1][2], wl[kk][1][3]};
#pragma unroll
                    for (int e = 0; e < 8; ++e) wv[e] = (s0 + e <= t) ? wv[e] : 0.f;
                    u32x4v wp; wp.x = cvt_pk_bf16(wv[0], wv[1]); wp.y = cvt_pk_bf16(wv[2], wv[3]); wp.z = cvt_pk_bf16(wv[4], wv[5]); wp.w = cvt_pk_bf16(wv[6], wv[7]);
                    const bf16x8 Wf = __builtin_bit_cast(bf16x8, wp);
#pragma unroll
                    for (int c = 0; c < 8; ++c) {
                        const bf16x8 Af = *(const LAS bf16x8*)(Vt + (g * 128 + c * 16 + fr) * 136 + kk * 32 + fq * 8);
                        acc[c] = __builtin_amdgcn_mfma_f32_16x16x32_bf16(Af, Wf, acc[c], 0, 0, 0);
                    }
                }
            }
#pragma unroll
            for (int c = 0; c < 8; ++c) {
                const int col = g * 128 + c * 16 + fq * 4;
                f32x4 o;
                o[0] = __uint_as_float(uv[c].x << 16) * (acc[c][0] + bias); o[1] = __uint_as_float(uv[c].x & 0xffff0000u) * (acc[c][1] + bias);
                o[2] = __uint_as_float(uv[c].y << 16) * (acc[c][2] + bias); o[3] = __uint_as_float(uv[c].y & 0xffff0000u) * (acc[c][3] + bias);
                *(u32x2*)(YS + row * 1536 + col) = pack4(o);
            }
        }
    }
    __syncthreads();
}

__device__ __forceinline__ void conv_rope_phase(const Args& a, int l, bool do_rope) {
    const int otid = opaque_tid();
    const bf16_t* C = (const bf16_t*)(a.ws + WS_R1 + R1_C);
    bf16_t* YS = (bf16_t*)(a.ws + WS_R2);
    const float* cw = a.in[I_CONVW] + (size_t)l * 3 * 512;
    const int gt = blockIdx.x * NTHR + otid, gn = gridDim.x * NTHR;
    const int bx = (int)blockIdx.x; const bool g256 = gridDim.x == 256;
    const bool cmpblk = g256 && ((bx & 63) < 16);
    const int vb = !g256 ? bx : (bx >> 6) * 48 + (bx & 63) - 16;
    const int cgt = vb * NTHR + otid, cgn = (g256 ? 192 : (int)gridDim.x) * NTHR;
    for (int i = cmpblk ? (NTOK / 4) * 64 : cgt; i < (NTOK / 4) * 64; i += cgn) {
        const int r0 = (i >> 6) * 4, c0 = (i & 63) * 8, s0 = r0 & 4095;
        u32x4v cgv[6], xtv[6], bgv[4];
#pragma unroll
        for (int k = 0; k < 6; ++k) {
            if (k >= 2 || s0 > 0) { const bf16_t* p = C + (size_t)(r0 - 2 + k) * 1536; cgv[k] = *(const u32x4v*)(p + 512 + c0); xtv[k] = *(const u32x4v*)(p + 1024 + c0); }
            else { cgv[k] = (u32x4v){0u, 0u, 0u, 0u}; xtv[k] = cgv[k]; }
        }
#pragma unroll
        for (int q = 0; q < 4; ++q) bgv[q] = *(const u32x4v*)(C + (size_t)(r0 + q) * 1536 + c0);
        float w0[8], w1[8], w2[8];
#pragma unroll
        for (int e = 0; e < 8; ++e) { w0[e] = cw[c0 + e]; w1[e] = cw[512 + c0 + e]; w2[e] = cw[1024 + c0 + e]; }
        float hc[6][8];
#pragma unroll
        for (int k = 0; k < 6; ++k) {
            const unsigned cgw[4] = {cgv[k].x, cgv[k].y, cgv[k].z, cgv[k].w}, xtw[4] = {xtv[k].x, xtv[k].y, xtv[k].z, xtv[k].w};
#pragma unroll
            for (int e = 0; e < 4; ++e) { hc[k][2 * e] = __uint_as_float(cgw[e] << 16) * __uint_as_float(xtw[e] << 16); hc[k][2 * e + 1] = __uint_as_float(cgw[e] & 0xffff0000u) * __uint_as_float(xtw[e] & 0xffff0000u); }
        }
#pragma unroll
        for (int q = 0; q < 4; ++q) {
            const unsigned bgw[4] = {bgv[q].x, bgv[q].y, bgv[q].z, bgv[q].w};
            float o[8];
#pragma unroll
            for (int e = 0; e < 8; ++e) {
                const float bv = (e & 1) ? __uint_as_float(bgw[e >> 1] & 0xffff0000u) : __uint_as_float(bgw[e >> 1] << 16);
                o[e] = bv * (w0[e] * hc[q][e] + w1[e] * hc[q + 1][e] + w2[e] * hc[q + 2][e]);
            }
            u32x4v w; w.x = cvt_pk_bf16(o[0], o[1]); w.y = cvt_pk_bf16(o[2], o[3]); w.z = cvt_pk_bf16(o[4], o[5]); w.w = cvt_pk_bf16(o[6], o[7]);
            *(u32x4v*)(YS + (size_t)(r0 + q) * 1536 + 1024 + c0) = w;
        }
    }
    bf16_t* KV = (bf16_t*)(a.ws + WS_R1 + R1_KV);
    const float* RT = (const float*)(a.ws + WS_ROPE);
    if (do_rope) for (int i = gt; i < 2 * 16 * 4096; i += gn) {
        const int wsel = i >> 16, rem = i & 65535, s = rem & 4095;
        bf16_t* p = KV + (size_t)(wsel ? 4 : 2) * KVSZ + (size_t)rem * 64;
        const u32x4v x1 = *(const u32x4v*)p, x2 = *(const u32x4v*)(p + 8);
        const unsigned a1[4] = {x1.x, x1.y, x1.z, x1.w}, a2[4] = {x2.x, x2.y, x2.z, x2.w};
        float r1[8], r2[8];
#pragma unroll
        for (int e = 0; e < 8; ++e) {
            const float v1 = (e & 1) ? __uint_as_float(a1[e >> 1] & 0xffff0000u) : __uint_as_float(a1[e >> 1] << 16);
            const float v2 = (e & 1) ? __uint_as_float(a2[e >> 1] & 0xffff0000u) : __uint_as_float(a2[e >> 1] << 16);
            const float cs = RT[(s * 8 + e) * 2], sn = RT[(s * 8 + e) * 2 + 1];
            r1[e] = v1 * cs - v2 * sn; r2[e] = v2 * cs + v1 * sn;
        }
        u32x4v o1, o2;
        o1.x = cvt_pk_bf16(r1[0], r1[1]); o1.y = cvt_pk_bf16(r1[2], r1[3]); o1.z = cvt_pk_bf16(r1[4], r1[5]); o1.w = cvt_pk_bf16(r1[6], r1[7]);
        o2.x = cvt_pk_bf16(r2[0], r2[1]); o2.y = cvt_pk_bf16(r2[2], r2[3]); o2.z = cvt_pk_bf16(r2[4], r2[5]); o2.w = cvt_pk_bf16(r2[6], r2[7]);
        *(u32x4v*)p = o1; *(u32x4v*)(p + 8) = o2;
    }
}

__device__ __forceinline__ void cmp2_phase(const Args& a, int l, LAS unsigned char* lds) {
    const int otid = opaque_tid();
    const int lane = otid & 63, w = otid >> 6;
    const float* UL = (const float*)(a.ws + WS_UL);
    const float* CB = (const float*)(a.ws + WS_CB1);
    bf16_t* KC = (bf16_t*)(a.ws + WS_KC);
    LAS float* hb = (LAS float*)lds + w * 512;
    const int nw = gridDim.x * 8;
    const int wv = blockIdx.x * 8 + w;
    if (nw == 2048) {
#pragma unroll
        for (int q = 0; q < 4; ++q) {
            const int rr = wv + q * 2048, kv = rr >> 12, r = rr & 4095, r1 = r + 1 > 4095 ? 4095 : r + 1;
            const float* U = UL + ((size_t)kv * 4096 + r) * 256; const float* L = UL + ((size_t)kv * 4096 + r1) * 256 + 128;
            const size_t P1 = (size_t)2 * 4096 * 256;
            hb[q * 128 + lane] = gelu_t((U[lane] + U[P1 + lane]) + (L[lane] + L[P1 + lane]) + CB[kv * 128 + lane]);
            hb[q * 128 + lane + 64] = gelu_t((U[lane + 64] + U[P1 + lane + 64]) + (L[lane + 64] + L[P1 + lane + 64]) + CB[kv * 128 + lane + 64]);
        }
        __syncthreads();
        const float* w2a = a.in[I_CW2] + (size_t)(l * 2 + 0) * 128 * 64 + lane; const float* w2b = a.in[I_CW2] + (size_t)(l * 2 + 1) * 128 * 64 + lane;
        float s0 = 0.f, s1 = 0.f, s2 = 0.f, s3 = 0.f;
#pragma unroll 16
        for (int h = 0; h < 128; ++h) { const float wa = w2a[h * 64], wb = w2b[h * 64]; s0 += hb[h] * wa; s1 += hb[128 + h] * wa; s2 += hb[256 + h] * wb; s3 += hb[384 + h] * wb; }
        KC[(size_t)(wv) * 64 + lane] = f2bf(s0); KC[(size_t)(wv + 2048) * 64 + lane] = f2bf(s1); KC[(size_t)(wv + 4096) * 64 + lane] = f2bf(s2); KC[(size_t)(wv + 6144) * 64 + lane] = f2bf(s3);
        __syncthreads();
    } else {
        for (int rr = wv; rr < 2 * 4096; rr += nw) {
            const int kv = rr >> 12, r = rr & 4095, r1 = r + 1 > 4095 ? 4095 : r + 1;
            const float* U = UL + ((size_t)kv * 4096 + r) * 256; const float* L = UL + ((size_t)kv * 4096 + r1) * 256 + 128;
            const float* w2 = a.in[I_CW2] + (size_t)(l * 2 + kv) * 128 * 64 + lane;
            float s0 = 0.f;
            for (int h = 0; h < 128; ++h) s0 += gelu_t((U[h] + U[(size_t)2 * 4096 * 256 + h]) + (L[h] + L[(size_t)2 * 4096 * 256 + h]) + CB[kv * 128 + h]) * w2[h * 64];
            KC[(size_t)rr * 64 + lane] = f2bf(s0);
        }
    }
}

constexpr int KSTR = 72;
enum { M_CMP1 = 0, M_CMP2 = 1, M_SLC = 2, M_WIN = 3 };

struct AttnState {
    bf16x8 qf[2][2];
    float m[2], l[2];
    f32x4 o[2][4];
};

constexpr float ATT_THR = 6.0f;
constexpr float ATT_QS = 0.125f * 1.4426950408889634f;

typedef short s16x4 __attribute__((ext_vector_type(4)));
__device__ __forceinline__ void attn_pv(AttnState& st, const LAS bf16_t* Vt, const bf16x8 (&pf)[2][2], int fr, int fq) {
    const LAS bf16_t* vb = Vt + (4 * fq + (fr >> 2)) * KSTR + 4 * (fr & 3);
#pragma unroll
    for (int kg = 0; kg < 2; ++kg)
#pragma unroll
        for (int dt = 0; dt < 4; ++dt) {
            const s16x4 v0 = __builtin_amdgcn_ds_read_tr16_b64_v4i16((LAS s16x4*)(vb + (kg * 32) * KSTR + dt * 16));
            const s16x4 v1 = __builtin_amdgcn_ds_read_tr16_b64_v4i16((LAS s16x4*)(vb + (kg * 32 + 16) * KSTR + dt * 16));
            const bf16x8 vf = {v0[0], v0[1], v0[2], v0[3], v1[0], v1[1], v1[2], v1[3]};
#pragma unroll
            for (int ct = 0; ct < 2; ++ct) st.o[ct][dt] = __builtin_amdgcn_mfma_f32_16x16x32_bf16(vf, pf[kg][ct], st.o[ct][dt], 0, 0, 0);
        }
}

template <int MODE, bool FAST, bool DEFER>
__device__ __forceinline__ void attn_tile(AttnState& st, const LAS bf16_t* Ks, const LAS bf16_t* Vt, int jb, int tq, bool mybit, int fr, int fq, float (&imp)[16], float& prev_t3, bf16x8 (&pfo)[2][2]) {
    constexpr bool ISCMP = (MODE == M_CMP1 || MODE == M_CMP2);
    f32x4 s[2][4];
    f32x4 zinit[2];
#pragma unroll
    for (int ct = 0; ct < 2; ++ct) { const float nb_ = !FAST ? 0.f : ((MODE == M_SLC && !mybit) ? -1e30f : (st.m[ct] < -1e29f ? 0.f : -st.m[ct])); zinit[ct] = (f32x4){nb_, nb_, nb_, nb_}; }
#pragma unroll
    for (int sb = 0; sb < 4; ++sb) {
        const bf16x8 k0 = *(const LAS bf16x8*)(Ks + (sb * 16 + fr) * KSTR + fq * 8);
        const bf16x8 k1 = *(const LAS bf16x8*)(Ks + (sb * 16 + fr) * KSTR + 32 + fq * 8);
#pragma unroll
        for (int ct = 0; ct < 2; ++ct) {
            f32x4 z = zinit[ct];
            z = __builtin_amdgcn_mfma_f32_16x16x32_bf16(k0, st.qf[ct][0], z, 0, 0, 0);
            z = __builtin_amdgcn_mfma_f32_16x16x32_bf16(k1, st.qf[ct][1], z, 0, 0, 0);
            s[ct][sb] = ISCMP ? z * ATT_QS : z;
        }
    }
    unsigned vbits = 0;
    if (!FAST) {
#pragma unroll
        for (int sb = 0; sb < 4; ++sb)
#pragma unroll
            for (int j = 0; j < 4; ++j) {
                const int kidx = jb * 64 + sb * 16 + fq * 4 + j;
                bool v;
                if (ISCMP) v = (16 * kidx + 31 <= tq);
                else if (MODE == M_SLC) v = mybit && (kidx <= tq);
                else v = (kidx <= tq) && (tq - kidx < 512);
                vbits |= (v ? 1u : 0u) << (sb * 4 + j);
            }
    }
    if (MODE == M_CMP2) {
        f32x4 p[2][4];
#pragma unroll
        for (int ct = 0; ct < 2; ++ct) {
            const float il = st.l[ct] > 0.f ? 1.f / st.l[ct] : 0.f;
#pragma unroll
            for (int sb = 0; sb < 4; ++sb)
#pragma unroll
                for (int j = 0; j < 4; ++j) p[ct][sb][j] = ((vbits >> (sb * 4 + j)) & 1u) ? __builtin_amdgcn_exp2f(s[ct][sb][j] - st.m[ct]) * il : 0.f;
        }
        {
            bf16x8 pfc[2][2];
#pragma unroll
            for (int kg = 0; kg < 2; ++kg)
#pragma unroll
                for (int ct = 0; ct < 2; ++ct) { u32x4v w; w.x = cvt_pk_bf16(p[ct][2 * kg][0], p[ct][2 * kg][1]); w.y = cvt_pk_bf16(p[ct][2 * kg][2], p[ct][2 * kg][3]);
                    w.z = cvt_pk_bf16(p[ct][2 * kg + 1][0], p[ct][2 * kg + 1][1]); w.w = cvt_pk_bf16(p[ct][2 * kg + 1][2], p[ct][2 * kg + 1][3]); pfc[kg][ct] = __builtin_bit_cast(bf16x8, w); }
            attn_pv(st, Vt, pfc, fr, fq);
        }
        const int lane = fq * 16 + fr;
#pragma unroll
        for (int sb = 0; sb < 4; ++sb) {
            float A = (p[0][sb][0] + p[0][sb][1] + p[0][sb][2]) + (p[1][sb][0] + p[1][sb][1] + p[1][sb][2]);
            float B = p[0][sb][3] + p[1][sb][3];
            A += __shfl_xor(A, 8); B += __shfl_xor(B, 8);
            const float xa = __shfl(B, (lane + 48) & 63), xb = __shfl(prev_t3, (lane + 48) & 63);
            const float pv = fq == 0 ? xb : xa;
            const float ival = A + 0.5f * B + 0.5f * pv;
#pragma unroll
            for (int T = 0; T < 4; ++T) if (jb == T) imp[T * 4 + sb] = ival;
            prev_t3 = B;
        }
        return;
    }
    if (FAST) {
        float tz[2]; bool nd[2]; bool un[2];
#pragma unroll
        for (int ct = 0; ct < 2; ++ct) {
            float t = -1e30f;
#pragma unroll
            for (int sb = 0; sb < 4; ++sb)
#pragma unroll
                for (int j = 0; j < 4; ++j) t = fmaxf(t, s[ct][sb][j]);
            t = fmaxf(t, __shfl_xor(t, 16)); t = fmaxf(t, __shfl_xor(t, 32));
            tz[ct] = t; un[ct] = st.m[ct] < -1e29f;
            nd[ct] = (t > -1e29f) && (t > ATT_THR || un[ct]);
        }
        if (__builtin_amdgcn_ballot_w64(nd[0] || nd[1]) != 0ull) {
#pragma unroll
            for (int ct = 0; ct < 2; ++ct) {
                const float dl = nd[ct] ? tz[ct] : 0.f;
                const float alpha = nd[ct] ? (un[ct] ? 0.f : __builtin_amdgcn_exp2f(-tz[ct])) : 1.f;
                st.m[ct] = nd[ct] ? ((un[ct] ? 0.f : st.m[ct]) + tz[ct]) : st.m[ct];
                st.l[ct] *= alpha;
#pragma unroll
                for (int dt = 0; dt < 4; ++dt) st.o[ct][dt] = st.o[ct][dt] * alpha;
#pragma unroll
                for (int sb = 0; sb < 4; ++sb) s[ct][sb] = s[ct][sb] - dl;
            }
        }
#pragma unroll
        for (int ct = 0; ct < 2; ++ct) {
            float ls = 0.f;
#pragma unroll
            for (int sb = 0; sb < 4; ++sb)
#pragma unroll
                for (int j = 0; j < 4; ++j) { const float pe = __builtin_amdgcn_exp2f(s[ct][sb][j]); s[ct][sb][j] = pe; ls += pe; }
            st.l[ct] += ls;
        }
    } else {
    float tmaxv[2]; bool need[2];
#pragma unroll
    for (int ct = 0; ct < 2; ++ct) {
        float tmax = -1e30f;
#pragma unroll
        for (int sb = 0; sb < 4; ++sb)
#pragma unroll
            for (int j = 0; j < 4; ++j) {
                if (!FAST) s[ct][sb][j] = ((vbits >> (sb * 4 + j)) & 1u) ? s[ct][sb][j] : -1e30f;
                tmax = fmaxf(tmax, s[ct][sb][j]);
            }
        if (FAST && MODE == M_SLC) tmax = mybit ? tmax : -1e30f;
        tmax = fmaxf(tmax, __shfl_xor(tmax, 16)); tmax = fmaxf(tmax, __shfl_xor(tmax, 32));
        tmaxv[ct] = tmax; need[ct] = tmax > st.m[ct] + ATT_THR;
    }
    if (__builtin_amdgcn_ballot_w64(need[0] || need[1]) != 0ull) {
#pragma unroll
        for (int ct = 0; ct < 2; ++ct) {
            const float alpha = need[ct] ? __builtin_amdgcn_exp2f(st.m[ct] - tmaxv[ct]) : 1.f;
            st.m[ct] = need[ct] ? tmaxv[ct] : st.m[ct];
            st.l[ct] *= alpha;
            if (MODE != M_CMP1) {
#pragma unroll
                for (int dt = 0; dt < 4; ++dt) st.o[ct][dt] = st.o[ct][dt] * alpha;
            }
        }
    }
#pragma unroll
    for (int ct = 0; ct < 2; ++ct) {
        const float mu = (FAST && MODE == M_SLC && !mybit) ? 1e30f : st.m[ct];
        float ls = 0.f;
#pragma unroll
        for (int sb = 0; sb < 4; ++sb)
#pragma unroll
            for (int j = 0; j < 4; ++j) {
                float pe = __builtin_amdgcn_exp2f(s[ct][sb][j] - mu);
                if (!FAST) pe = ((vbits >> (sb * 4 + j)) & 1u) ? pe : 0.f;
                s[ct][sb][j] = pe; ls += pe;
            }
        st.l[ct] += ls;
    }
    }
    if (MODE != M_CMP1) {
#pragma unroll
        for (int kg = 0; kg < 2; ++kg)
#pragma unroll
            for (int ct = 0; ct < 2; ++ct) { u32x4v w; w.x = cvt_pk_bf16(s[ct][2 * kg][0], s[ct][2 * kg][1]); w.y = cvt_pk_bf16(s[ct][2 * kg][2], s[ct][2 * kg][3]);
                w.z = cvt_pk_bf16(s[ct][2 * kg + 1][0], s[ct][2 * kg + 1][1]); w.w = cvt_pk_bf16(s[ct][2 * kg + 1][2], s[ct][2 * kg + 1][3]); pfo[kg][ct] = __builtin_bit_cast(bf16x8, w); }
        if (!DEFER) attn_pv(st, Vt, pfo, fr, fq);
    }
}

template <int MODE>
__device__ __forceinline__ void attn_branch(AttnState& st, const bf16_t* __restrict__ Kg, const bf16_t* __restrict__ Vg, u64 tiles, LAS bf16_t* KsB, LAS bf16_t* VtB,
                                            int tq, u64 mymask, int cur, int fr, int fq, float (&imp)[16]) {
    const int otid = opaque_tid();
    const int tid = otid;
    const int kkey = tid >> 3, kch = tid & 7;
    const bool late = false;
    float prev_t3 = 0.f;
    if (tiles == 0ull) return;
    int jb = __builtin_ctzll(tiles); tiles &= tiles - 1ull;
    u32x4v kr = *(const u32x4v*)(Kg + (size_t)(jb * 64 + kkey) * 64 + kch * 8), vr = (u32x4v){0u, 0u, 0u, 0u};
    if (MODE != M_CMP1) vr = *(const u32x4v*)(Vg + (size_t)(jb * 64 + kkey) * 64 + kch * 8);
    int pb = 0, vb = 0, vprev = 0; bool have = false;
    bf16x8 pf[2][2];
    for (;;) {
        LAS bf16_t* Ks = KsB + pb * (64 * KSTR); LAS bf16_t* Vt = VtB + vb * (64 * KSTR);
        *(LAS u32x4v*)(Ks + kkey * KSTR + kch * 8) = kr;
        if (MODE != M_CMP1) *(LAS u32x4v*)(Vt + kkey * KSTR + kch * 8) = vr;
        int jn = -1;
        if (tiles != 0ull) { jn = __builtin_ctzll(tiles); tiles &= tiles - 1ull;
            kr = *(const u32x4v*)(Kg + (size_t)(jn * 64 + kkey) * 64 + kch * 8);
            if (MODE != M_CMP1) vr = *(const u32x4v*)(Vg + (size_t)(jn * 64 + kkey) * 64 + kch * 8); }
        __syncthreads();
        if (late && have) { attn_pv(st, VtB + vprev * (64 * KSTR), pf, fr, fq); have = false; }
        const bool mybit = (mymask >> jb) & 1ull;
        bool active = true;
        if (MODE == M_SLC) active = __builtin_amdgcn_ballot_w64(mybit) != 0ull;
        if (active) {
            if (MODE == M_SLC || MODE == M_WIN) {
                const bool fast = (MODE == M_SLC) ? (jb != cur) : (jb != cur && jb != cur - 8);
                if (fast) attn_tile<MODE, true, true>(st, Ks, Vt, jb, tq, mybit, fr, fq, imp, prev_t3, pf); else attn_tile<MODE, false, true>(st, Ks, Vt, jb, tq, mybit, fr, fq, imp, prev_t3, pf);
                if (late) { have = true; vprev = vb; } else attn_pv(st, Vt, pf, fr, fq);
            } else attn_tile<MODE, false, false>(st, Ks, Vt, jb, tq, mybit, fr, fq, imp, prev_t3, pf);
        }
        if (jn < 0) break;
        jb = jn; pb ^= 1; vb = vb == 2 ? 0 : vb + 1;
    }
    if (late && have) attn_pv(st, VtB + vprev * (64 * KSTR), pf, fr, fq);
    __syncthreads();
}

__device__ __forceinline__ void attn_phase(const Args& a, LAS unsigned char* lds) {
    const int otid = opaque_tid();
    const bf16_t* Q = (const bf16_t*)(a.ws + WS_R1 + R1_Q);
    const bf16_t* KV = (const bf16_t*)(a.ws + WS_R1 + R1_KV);
    const bf16_t* KC = (const bf16_t*)(a.ws + WS_KC);
    const float* NG = (const float*)(a.ws + WS_NG);
    const float* RT = (const float*)(a.ws + WS_ROPE);
    bf16_t* YS = (bf16_t*)(a.ws + WS_R2);
    LAS bf16_t* Ks = (LAS bf16_t*)lds;
    LAS bf16_t* Vt = (LAS bf16_t*)(lds + 2 * 64 * KSTR * 2);
    LAS u64* um = (LAS u64*)(lds + 5 * 64 * KSTR * 2);
    const int tid = otid, lane = tid & 63, w = tid >> 6, fr = lane & 15, fq = lane >> 4;
    for (int i = blockIdx.x; i < 1024; i += gridDim.x) {
        const int c = i & 255, itn = i >> 8, bg = (c & 7) * 2 + (c >> 7), mm = (c >> 3) & 15;
        const int qb = itn == 0 ? mm : (itn == 1 ? 31 - mm : (itn == 2 ? 32 + mm : 63 - mm));
        const int b = bg >> 1, g = bg & 1, q0 = qb * 64, cur = qb;
        const int tq = q0 + 8 * w + (fr & 7);
        const size_t row = (size_t)b * SQ + tq;
        AttnState st;
        LAS float* oacc = (LAS float*)(lds + 49152) + tid;
        float imp[16];
#pragma unroll
        for (int k = 0; k < 16; ++k) imp[k] = 0.f;
#pragma unroll
        for (int ct = 0; ct < 2; ++ct) { const int h = g * 4 + 2 * ct + (fr >> 3);
#pragma unroll
            for (int kk = 0; kk < 2; ++kk) st.qf[ct][kk] = __builtin_bit_cast(bf16x8, *(const u32x4v*)(Q + row * 512 + h * 64 + kk * 32 + fq * 8)); }
        const bf16_t* kc = KC + (size_t)bg * 256 * 64; const bf16_t* vc = KC + (size_t)(16 + bg) * 256 * 64;
#pragma unroll
        for (int ct = 0; ct < 2; ++ct) { st.m[ct] = -1e30f; st.l[ct] = 0.f;
#pragma unroll
            for (int dt = 0; dt < 4; ++dt) st.o[ct][dt] = (f32x4){0.f, 0.f, 0.f, 0.f}; }
        const int ncmp = (q0 + 32) / 1024 + 1;
        const u64 cmpt = (1ull << (ncmp > 4 ? 4 : ncmp)) - 1ull;
        attn_branch<M_CMP1>(st, kc, vc, cmpt, Ks, Vt, tq, 0ull, cur, fr, fq, imp);
#pragma unroll
        for (int ct = 0; ct < 2; ++ct) { float lt = st.l[ct]; lt += __shfl_xor(lt, 16); lt += __shfl_xor(lt, 32); st.l[ct] = lt; }
        attn_branch<M_CMP2>(st, kc, vc, cmpt, Ks, Vt, tq, 0ull, cur, fr, fq, imp);
        {
#pragma unroll
            for (int ct = 0; ct < 2; ++ct) { const int h = g * 4 + 2 * ct + (fr >> 3); const float gt = sigm(NG[row * 24 + h * 3 + 0]);
#pragma unroll
                for (int dt = 0; dt < 4; ++dt)
#pragma unroll
                    for (int j = 0; j < 4; ++j) oacc[((ct * 4 + dt) * 4 + j) * 512] = st.o[ct][dt][j] * gt; }
        }
        u64 mymask = 0ull;
        if (cur < 16) mymask = (2ull << cur) - 1ull;
        else {
            float sc[16]; int rank[16];
#pragma unroll
            for (int k = 0; k < 16; ++k) { const int jb = 4 * k + fq; const bool forced = (jb == 0) || (jb == cur) || (jb == cur - 1);
                sc[k] = forced ? 1e4f : (jb <= cur ? imp[k] : -1.f); rank[k] = 0; }
#pragma unroll 1
            for (int f2 = 0; f2 < 4; ++f2)
#pragma unroll
                for (int k2 = 0; k2 < 16; ++k2) {
                    const float ov = __shfl(sc[k2], fr + 16 * f2); const int ob = 4 * k2 + f2;
#pragma unroll
                    for (int k = 0; k < 16; ++k) { const int jb = 4 * k + fq; rank[k] += ((ov > sc[k]) || (ov == sc[k] && ob < jb)) ? 1 : 0; }
                }
#pragma unroll
            for (int k = 0; k < 16; ++k) { const int jb = 4 * k + fq; if (rank[k] < 16 && jb <= cur) mymask |= 1ull << jb; }
            mymask |= __shfl_xor(mymask, 16); mymask |= __shfl_xor(mymask, 32);
        }
        u64 un = mymask;
        un |= __shfl_xor(un, 1); un |= __shfl_xor(un, 2); un |= __shfl_xor(un, 4);
        __syncthreads();
        { const int t2 = opaque_tid(); if ((t2 & 63) == 0) um[t2 >> 6] = un; }
        __syncthreads();
        u64 bun = 0ull;
#pragma unroll
        for (int k = 0; k < 8; ++k) bun |= um[k];
        {
            u32x4v qvl[2][2];
#pragma unroll
            for (int ct = 0; ct < 2; ++ct)
#pragma unroll
                for (int kk = 0; kk < 2; ++kk) { const int hq = g * 4 + 2 * ct + (fr >> 3); qvl[ct][kk] = *(const u32x4v*)(Q + row * 512 + hq * 64 + kk * 32 + fq * 8); }
            float cs[8], sn[8];
#pragma unroll
            for (int e = 0; e < 8; ++e) { cs[e] = RT[(tq * 8 + e) * 2]; sn[e] = RT[(tq * 8 + e) * 2 + 1]; }
#pragma unroll
            for (int ct = 0; ct < 2; ++ct)
#pragma unroll
                for (int kk = 0; kk < 2; ++kk) {
                    const u32x4v qv = qvl[ct][kk];
                    const unsigned qw[4] = {qv.x, qv.y, qv.z, qv.w};
                    float r[8];
#pragma unroll
                    for (int e = 0; e < 8; ++e) {
                        const float x = (e & 1) ? __uint_as_float(qw[e >> 1] & 0xffff0000u) : __uint_as_float(qw[e >> 1] << 16);
                        if (kk == 0) { const float ot = __shfl_xor(x, 16); r[e] = (fq == 0 ? x * cs[e] - ot * sn[e] : (fq == 1 ? x * cs[e] + ot * sn[e] : x)) * ATT_QS; }
                        else r[e] = x * ATT_QS;
                    }
                    u32x4v o; o.x = cvt_pk_bf16(r[0], r[1]); o.y = cvt_pk_bf16(r[2], r[3]); o.z = cvt_pk_bf16(r[4], r[5]); o.w = cvt_pk_bf16(r[6], r[7]);
                    st.qf[ct][kk] = __builtin_bit_cast(bf16x8, o);
                }
        }
#pragma unroll
        for (int ct = 0; ct < 2; ++ct) { st.m[ct] = -1e30f; st.l[ct] = 0.f;
#pragma unroll
            for (int dt = 0; dt < 4; ++dt) st.o[ct][dt] = (f32x4){0.f, 0.f, 0.f, 0.f}; }
        attn_branch<M_SLC>(st, KV + 2 * KVSZ + (size_t)bg * 4096 * 64, KV + 3 * KVSZ + (size_t)bg * 4096 * 64, bun, Ks, Vt, tq, mymask, cur, fr, fq, imp);
#pragma unroll
        for (int ct = 0; ct < 2; ++ct) { const int h = g * 4 + 2 * ct + (fr >> 3); float lt = st.l[ct]; lt += __shfl_xor(lt, 16); lt += __shfl_xor(lt, 32);
            const float gt = sigm(NG[row * 24 + h * 3 + 1]) * (lt > 0.f ? 1.f / lt : 0.f);
#pragma unroll
            for (int dt = 0; dt < 4; ++dt)
#pragma unroll
                for (int j = 0; j < 4; ++j) oacc[((ct * 4 + dt) * 4 + j) * 512] += st.o[ct][dt][j] * gt; }
#pragma unroll
        for (int ct = 0; ct < 2; ++ct) { st.m[ct] = -1e30f; st.l[ct] = 0.f;
#pragma unroll
            for (int dt = 0; dt < 4; ++dt) st.o[ct][dt] = (f32x4){0.f, 0.f, 0.f, 0.f}; }
        {
            const int lo = cur - 8 < 0 ? 0 : cur - 8;
            const u64 hi_m = cur == 63 ? ~0ull : ((1ull << (cur + 1)) - 1ull);
            const u64 wt = hi_m & ~((1ull << lo) - 1ull);
            attn_branch<M_WIN>(st, KV + 4 * KVSZ + (size_t)bg * 4096 * 64, KV + 5 * KVSZ + (size_t)bg * 4096 * 64, wt, Ks, Vt, tq, 0ull, cur, fr, fq, imp);
        }
#pragma unroll
        for (int ct = 0; ct < 2; ++ct) { const int h = g * 4 + 2 * ct + (fr >> 3); float lt = st.l[ct]; lt += __shfl_xor(lt, 16); lt += __shfl_xor(lt, 32);
            const float gt = sigm(NG[row * 24 + h * 3 + 2]) * (lt > 0.f ? 1.f / lt : 0.f);
#pragma unroll
            for (int dt = 0; dt < 4; ++dt) { f32x4 v;
#pragma unroll
                for (int j = 0; j < 4; ++j) v[j] = oacc[((ct * 4 + dt) * 4 + j) * 512] + st.o[ct][dt][j] * gt;
                *(u32x2*)(YS + row * 1536 + 512 + h * 64 + dt * 16 + fq * 4) = pack4(v); } }
    }
    __syncthreads();
}
#define XB_TMO      128
#define XB_XCNT(j)  (256  + 64 * (j))
#define XB_XSUB(j)  (1280 + 64 * (j))
#define XB_XGEN(j)  (2304 + 64 * (j))
#define XB_TOP      3328
#define XB_TOPGEN   3392
#define XCD_BAR_WORDS 3456
#define XB_SPIN_CAP (1u << 18)

__device__ __forceinline__ unsigned xb_ld(unsigned* p)              { return __hip_atomic_load(p, __ATOMIC_RELAXED, __HIP_MEMORY_SCOPE_AGENT); }
__device__ __forceinline__ unsigned xb_add(unsigned* p, unsigned v) { return __hip_atomic_fetch_add(p, v, __ATOMIC_RELAXED, __HIP_MEMORY_SCOPE_AGENT); }
__device__ __forceinline__ unsigned xb_xcc_id() { return (unsigned)__builtin_amdgcn_s_getreg((3 << 11) | 20) & 0xFu; }
#define XB_SPIN(cond, bar) do { unsigned _sp = 0; while (cond) { __builtin_amdgcn_s_sleep(1); \
    if ((++_sp & 255u) == 0u) { if (xb_ld(&(bar)[XB_TMO])) break; if (_sp > XB_SPIN_CAP) { atomicAdd(&(bar)[XB_TMO], 1u); break; } } } } while (0)

struct XcdBarrier {
    unsigned* bar; unsigned x;
    volatile LAS unsigned* st;
};

__device__ __forceinline__ XcdBarrier xcd_barrier_post(unsigned* bar, volatile LAS unsigned* st) {
    XcdBarrier b; b.bar = bar; b.x = xb_xcc_id(); b.st = st;
    if (threadIdx.x == 0) (void)xb_add(&bar[XB_XCNT(b.x)], 1u);
    return b;
}
__device__ __forceinline__ void xcd_barrier_complete(unsigned* bar, unsigned x, unsigned& nloc, unsigned& nx) {
    const unsigned G = gridDim.x * gridDim.y * gridDim.z;
    unsigned sum, cnt, mine, sp = 0u;
    for (;;) {
        sum = 0u; cnt = 0u; mine = 0u;
#pragma unroll
        for (unsigned j = 0; j < 16; ++j) { const unsigned c = xb_ld(&bar[XB_XCNT(j)]); sum += c; cnt += (c > 0u) ? 1u : 0u; mine = (j == x) ? c : mine; }
        if (sum == G) break;
        __builtin_amdgcn_s_sleep(1);
        if ((++sp & 255u) == 0u) { if (xb_ld(&bar[XB_TMO])) break; if (sp > XB_SPIN_CAP) { atomicAdd(&bar[XB_TMO], 1u); break; } }
    }
    nloc = mine > 0u ? mine : 1u; nx = cnt > 0u ? cnt : 1u;
}

__device__ __forceinline__ void xcd_barrier(const XcdBarrier& b) {
    asm volatile("s_waitcnt vmcnt(0)" ::: "memory");
    __syncthreads();
    if (threadIdx.x == 0) {
        unsigned* bar = b.bar;
        __builtin_amdgcn_s_waitcnt(0);
        unsigned nloc = b.st[0], nx = b.st[1];
        if (nloc == 0u) { xcd_barrier_complete(bar, b.x, nloc, nx); b.st[0] = nloc; b.st[1] = nx; }
        const unsigned old = xb_add(&bar[XB_XSUB(b.x)], 1u);
        const unsigned gen = old / nloc;
        if (old + 1u == (gen + 1u) * nloc) {
            __builtin_amdgcn_fence(__ATOMIC_RELEASE, "agent");
            asm volatile("s_waitcnt vmcnt(0)" ::: "memory");
            const unsigned og = xb_add(&bar[XB_TOP], 1u);
            const unsigned tg = og / nx;
            if (og + 1u == (tg + 1u) * nx) xb_add(&bar[XB_TOPGEN], 1u);
            else XB_SPIN(xb_ld(&bar[XB_TOPGEN]) == tg, bar);
            __builtin_amdgcn_fence(__ATOMIC_ACQUIRE, "agent");
            xb_add(&bar[XB_XGEN(b.x)], 1u);
            asm volatile("s_waitcnt vmcnt(0)" ::: "memory");
        } else {
            XB_SPIN(xb_ld(&bar[XB_XGEN(b.x)]) == gen, bar);
            __builtin_amdgcn_fence(__ATOMIC_ACQUIRE, "agent");
            asm volatile("s_waitcnt vmcnt(0)" ::: "memory");
        }
    }
    __syncthreads();
}

#ifndef REP_SYNC
#define REP_SYNC 1
#endif
#ifndef USE_CG
#define USE_CG 0
#endif
#define GSYNC() do { for (int rs_ = 0; rs_ < REP_SYNC; ++rs_) { if (USE_CG) grid.sync(); else xcd_barrier(xbar); } } while (0)
#ifndef PROBE_NORM
#define PROBE_NORM 0
#endif
#ifndef PROBE_CB
#define PROBE_CB 0
#endif
#ifndef REP_ATTN
#define REP_ATTN 1
#endif
#ifndef REP_FFN
#define REP_FFN 1
#endif
#ifndef REP_MIXG
#define REP_MIXG 1
#endif
#ifndef REP_SMALL
#define REP_SMALL 1
#endif
#ifndef REP_PRO
#define REP_PRO 1
#endif
__global__ void __launch_bounds__(NTHR) mega_fwd(Args a) {
    extern __shared__ __attribute__((aligned(16))) unsigned char lds_raw[];
    LAS unsigned char* lds = (LAS unsigned char*)lds_raw;
    cg::grid_group grid = cg::this_grid();
    unsigned char* ws = a.ws;
    bf16_t* H = (bf16_t*)(ws + WS_H);
    bf16_t* ACT = (bf16_t*)(ws + WS_R1 + R1_ACT);
    bf16_t* Y1 = (bf16_t*)(ws + WS_R1 + R1_Y1);
    bf16_t* Y2 = (bf16_t*)(ws + WS_R2);
    bf16_t* GATES = (bf16_t*)(ws + WS_R1 + R1_GATES);
    bf16_t* YS = (bf16_t*)(ws + WS_R2);
    const float* MOD = (const float*)(ws + WS_MOD);
    const float* NG_ = a.in[I_NORMG];

    volatile LAS unsigned* xst = (volatile LAS unsigned*)(lds + LDS_BYTES - 16);
    if (threadIdx.x == 0) { xst[0] = 0u; xst[1] = 0u; xst[2] = 0u; xst[3] = 0u; }
    __syncthreads();
    XcdBarrier xbar = xcd_barrier_post((unsigned*)(ws + WS_BAR), xst);
    for (int rep = 0; rep < REP_PRO; ++rep) {
    convert_weights(a, 0, lds);
    __syncthreads();
    mod_rope_phase(a, lds);
    if (a.ws == nullptr) grid.sync();
    GSYNC();
    }
    norm_phase(a.in[I_X], false, nullptr, nullptr, nullptr, 0.f, NG_ + 0 * DM, MOD + 0 * DM, MOD + 1 * DM, nullptr, false, H);
    GSYNC();
#pragma unroll 1
    for (int hl = 0; hl < 4; ++hl) {
        const int l = hl >> 1, f = hl & 1;
        const float* ng = NG_ + (size_t)l * 6 * DM;
        const float* mod = MOD + (size_t)l * 8 * 9216;
        for (int rep = 0; rep < REP_FFN; ++rep) {
        { EpiSwiglu E; E.O = ACT; run_gemm(lds, H, 1024, (const bf16_t*)(ws + WS_W13 + f * SZ_W13), 1024, NTOK, 5632, 1024, 1 << 20, 0, E); }
        GSYNC();
        { EpiPlain E; E.O = Y1; E.ldc = DM; run_gemm(lds, ACT, DFF, (const bf16_t*)(ws + WS_W2 + f * SZ_W2), DFF, NTOK, 1024, DFF, 1 << 20, 0, E); }
        GSYNC();
        }
        if (f == 0) {
            norm_phase(l == 0 ? (const void*)a.in[I_X] : (const void*)a.out, l != 0, Y1, ng + 1 * DM, mod + 2 * DM, 0.5f, ng + 2 * DM, mod + 3 * DM, mod + 4 * DM, a.out, true, H);
            GSYNC();
            for (int rep = 0; rep < REP_MIXG; ++rep) {
            { EpiWin E; E.AIN = (bf16_t*)(ws + WS_R1 + R1_AIN); E.Q = (bf16_t*)(ws + WS_R1 + R1_Q); E.KV = (bf16_t*)(ws + WS_R1 + R1_KV); E.C = (bf16_t*)(ws + WS_R1 + R1_C); E.NG = (float*)(ws + WS_NG);
              run_gemm(lds, H, 1024, (const bf16_t*)(ws + WS_WIN), 1024, NTOK, 4096, 1024, 1 << 20, 0, E); }
            GSYNC();
            }
            for (int rep = 0; rep < REP_SMALL; ++rep) gmlp_phase(a, l, lds);
            if (PROBE_CB) conv_rope_phase(a, l, false);
            conv_rope_phase(a, l, true);
            for (int rep = 0; rep < REP_SMALL; ++rep)
            for (int kk2 = 0; kk2 < 4; ++kk2) {
                const int kv = kk2 >> 1, kh = kk2 & 1;
                EpiUL E; E.O = (float*)(ws + WS_UL) + (size_t)(kh * 2 + kv) * 4096 * 256;
                run_gemm(lds, (const bf16_t*)(ws + WS_R1 + R1_KV) + (size_t)kv * KVSZ + kh * 512, 1024, (const bf16_t*)(ws + WS_WC1) + (size_t)kv * 256 * 1024 + kh * 512, 1024, 4096, 256, 512, 1 << 20, 0, E, 64 * kk2);
            }
            GSYNC();
            for (int rep = 0; rep < REP_SMALL; ++rep) cmp2_phase(a, l, lds);
            GSYNC();
            for (int rep = 0; rep < REP_ATTN; ++rep) {
            attn_phase(a, lds);
            GSYNC();
            }
            for (int rep = 0; rep < REP_MIXG; ++rep) {
            { EpiSigmoid E; E.O = GATES; E.ldc = 3072; run_gemm(lds, H, 1024, (const bf16_t*)(ws + WS_WG), 1024, NTOK, 3072, 1024, 1 << 20, 0, E); }
            GSYNC();
            }
            { EpiBranchAcc E; E.G = GATES; E.Mg = H;
              pg8::Gemm g; g.A = YS; g.Bt = (const bf16_t*)(ws + WS_WB); g.M = NTOK; g.N = 3072; g.K = 512; g.lda = 1536; g.ldb = 512; g.adiv = 4; g.aoff = 512;
              BranchOrder S; S.init(NTOK, (int)gridDim.x, (int)blockIdx.x);
              pg8::gemm_phase<EpiBranchAcc, BranchOrder, true, true>((PG8_LAS unsigned char*)lds, g, S, E);
              __syncthreads(); }
            GSYNC();
            for (int rep = 0; rep < REP_MIXG; ++rep) {
            { EpiPlain E; E.O = Y2; E.ldc = DM; run_gemm(lds, H, 1024, (const bf16_t*)(ws + WS_WO3), 1024, NTOK, 1024, 1024, 1 << 20, 0, E); }
            GSYNC();
            }
            norm_phase(a.out, true, Y2, ng + 3 * DM, mod + 5 * DM, 1.0f, ng + 4 * DM, mod + 6 * DM, mod + 7 * DM, l == 0 ? (void*)a.out : (void*)Y2, true, H);
            GSYNC();
        } else {
            if (l == 0) {
                norm_phase(a.out, true, Y1, ng + 5 * DM, mod + 8 * DM, 0.5f, NG_ + (size_t)6 * DM, MOD + (size_t)8 * 9216 + 0 * DM, MOD + (size_t)8 * 9216 + 1 * DM, a.out, true, H);
                convert_weights(a, 1, lds);
            } else {
                norm_phase(Y2, true, Y1, ng + 5 * DM, mod + 8 * DM, 0.5f, nullptr, nullptr, nullptr, a.out, false, nullptr);
            }
            GSYNC();
        }
    }
}

extern "C" void kernel_launch(void* const* d_in, const int* in_sizes, int n_in, void* d_out, int out_size, void* d_ws, size_t ws_size, hipStream_t stream) {
    static int grid = 0;
    if (grid == 0) {
        if (n_in != N_IN || ws_size < WS_END) { fprintf(stderr, "kernel_launch: bad n_in %d or ws_size %zu (need %zu)\n", n_in, ws_size, (size_t)WS_END); grid = -1; return; }
        int dev = 0, cus = 0, per_cu = 0;
        hipGetDevice(&dev);
        hipDeviceGetAttribute(&cus, hipDeviceAttributeMultiprocessorCount, dev);
        if (hipFuncSetAttribute((const void*)mega_fwd, hipFuncAttributeMaxDynamicSharedMemorySize, LDS_BYTES) != hipSuccess) { fprintf(stderr, "kernel_launch: hipFuncSetAttribute failed\n"); grid = -1; return; }
        hipOccupancyMaxActiveBlocksPerMultiprocessor(&per_cu, (const void*)mega_fwd, NTHR, LDS_BYTES);
        (void)hipGetLastError();
        if (per_cu < 1) per_cu = 1;
        grid = cus * 1;
        fprintf(stderr, "kernel_launch: cus %d per_cu %d grid %d\n", cus, per_cu, grid);
    }
    if (grid < 0) return;
    if (hipMemsetAsync((unsigned char*)d_ws + WS_BAR, 0, XCD_BAR_WORDS * 4, stream) != hipSuccess) { fprintf(stderr, "kernel_launch: memset failed\n"); return; }
    Args a{};
    for (int i = 0; i < N_IN; ++i) a.in[i] = (const float*)d_in[i];
    a.out = (float*)d_out; a.ws = (unsigned char*)d_ws;
    void* args[] = {&a};
    hipError_t e = hipLaunchCooperativeKernel((const void*)mega_fwd, dim3(grid), dim3(NTHR), args, LDS_BYTES, stream);
    if (e != hipSuccess) fprintf(stderr, "cooperative launch failed: %s (grid %d)\n", hipGetErrorString(e), grid);
}
```
